# Optimizing an MI355X kernel written in HIP

```python
import math
import jax, jax.numpy as jnp
from jax import lax
import numpy as np

D_MODEL = 1024
BATCH = 16
SEQ = 256
DEPTH = 4
DEC_BATCH = 4
DEC_SEQ = 2048
PAST_LEN = 512

GRID_W = 64
N_EVEN = (DEPTH + 1) // 2
N_ODD = DEPTH // 2
N_MOD = 9
D_FF = 2816
H_A = 8
NOPE_A = 64
ROPE_A = 32
V_A = 64
Q_LORA = 384
KV_LORA = 256
H_B = 4
DH_B = 64
DV_B = 2 * DH_B
H_C = 4
DK_C = 64
DV_C = 128
GATE_RANK = 16
GATE_TAU = 16.0
H_D = 4
DK_D = 64
DV_D = 128
CHUNK = 64
Q_BLOCK = 128
ROPE_BASE = 10000.0
EPS = 1e-6

EVEN_SIZES = (Q_LORA, KV_LORA, ROPE_A, H_B * 2 * DH_B, H_B * 2 * DH_B, H_B * DV_B)
EVEN_CUTS = [sum(EVEN_SIZES[:i + 1]) for i in range(len(EVEN_SIZES) - 1)]
IN_EVEN = sum(EVEN_SIZES)
ODD_SIZES = (H_C * DK_C, H_C * DK_C, H_C * DV_C, 2 * GATE_RANK, H_C * DV_C,
             H_D * DK_D, H_D * DK_D, H_D * DV_D, H_D * DV_D)
ODD_CUTS = [sum(ODD_SIZES[:i + 1]) for i in range(len(ODD_SIZES) - 1)]
IN_ODD = sum(ODD_SIZES)
MIX_EVEN = H_A * V_A + H_B * DV_B
MIX_ODD = H_C * DV_C + H_D * DV_D

kernel_name = "hybrid_diffusion_prefix_step"

F32 = jnp.float32


def rmsnorm(x, g):
    xf = x.astype(F32)
    y = xf * lax.rsqrt(jnp.mean(xf * xf, axis=-1, keepdims=True) + EPS)
    return (y * g.astype(F32)).astype(x.dtype)


def group_norm(x, g):
    xf = x.astype(F32)
    mu = jnp.mean(xf, axis=-1, keepdims=True)
    var = jnp.mean(jnp.square(xf - mu), axis=-1, keepdims=True)
    return ((xf - mu) * lax.rsqrt(var + EPS) * g.astype(F32)).astype(x.dtype)


def rope_1d(x, pos):
    n = x.shape[-1]
    half = n // 2
    inv = ROPE_BASE ** (-jnp.arange(half, dtype=F32) * 2.0 / n)
    ang = pos[:, None] * inv[None, :]
    shp = (1, pos.shape[0]) + (1,) * (x.ndim - 3) + (half,)
    cos = jnp.cos(ang).reshape(shp)
    sin = jnp.sin(ang).reshape(shp)
    xf = x.astype(F32)
    x1, x2 = xf[..., :half], xf[..., half:]
    return jnp.concatenate([x1 * cos - x2 * sin, x2 * cos + x1 * sin], axis=-1).astype(x.dtype)


def rope_2d(x, row, col):
    n = x.shape[-1]
    return jnp.concatenate([rope_1d(x[..., :n // 2], row), rope_1d(x[..., n // 2:], col)], axis=-1)


def adaln(cond, w, b):
    m = jax.nn.silu(cond) @ w + b
    return m.reshape(cond.shape[0], 1, N_MOD, D_MODEL)


def modulate(x, g, shift, scale):
    return rmsnorm(x, g) * (1.0 + scale) + shift


def swiglu(x, wg, wu, wd):
    return (jax.nn.silu(x @ wg) * (x @ wu)) @ wd


def ffn_half(x, m, j, g, wg, wu, wd):
    return x + 0.5 * m[:, :, j + 2] * swiglu(modulate(x, g, m[:, :, j], m[:, :, j + 1]), wg, wu, wd)


def sweep_queries(fn, qs):
    b, t = qs[0].shape[:2]
    nb = t // Q_BLOCK
    blocks = tuple(jnp.moveaxis(q.reshape((b, nb, Q_BLOCK) + q.shape[2:]), 1, 0) for q in qs)
    out = lax.map(lambda qb: fn(*qb), blocks)
    return jnp.moveaxis(out, 0, 1).reshape((b, t) + out.shape[3:])


def mla_attend(q_nope, q_rope, k_nope, k_rope, v):
    scale = (NOPE_A + ROPE_A) ** -0.5

    def blk(qn, qr):
        s = (jnp.einsum('bqhd,bkhd->bhqk', qn, k_nope)
             + jnp.einsum('bqhr,bkr->bhqk', qr, k_rope)).astype(F32) * scale
        p = jax.nn.softmax(s, axis=-1).astype(v.dtype)
        return jnp.einsum('bhqk,bkhd->bqhd', p, v)

    return sweep_queries(blk, (q_nope, q_rope))


def diff_attend(q1, q2, k1, k2, v, lam):
    scale = DH_B ** -0.5

    def blk(q1b, q2b):
        s1 = jnp.einsum('bqhd,bkhd->bhqk', q1b, k1).astype(F32) * scale
        s2 = jnp.einsum('bqhd,bkhd->bhqk', q2b, k2).astype(F32) * scale
        p = jax.nn.softmax(s1, axis=-1) - lam * jax.nn.softmax(s2, axis=-1)
        return jnp.einsum('bhqk,bkhd->bqhd', p.astype(v.dtype), v)

    return sweep_queries(blk, (q1, q2))


def chunk_scan(q, k, v, g, s0):
    b, t, h, _ = q.shape
    nc = t // CHUNK
    g = g.astype(q.dtype)

    def to_chunks(a):
        return jnp.moveaxis(a.reshape((b, nc, CHUNK) + a.shape[2:]), 1, 0)

    mask = jnp.tril(jnp.ones((CHUNK, CHUNK), dtype=bool))[None, :, :, None, None]

    def step(s, inp):
        qc, kc, vc, gc = inp
        bc = jnp.cumsum(gc, axis=1)
        diff = bc[:, :, None] - bc[:, None]
        dec = jnp.exp(jnp.where(mask, diff, -jnp.inf))
        a = jnp.sum(qc[:, :, None] * kc[:, None] * dec, axis=-1)
        o = (jnp.einsum('btsh,bshv->bthv', a, vc)
             + jnp.einsum('bthk,bhkv->bthv', qc * jnp.exp(bc), s))
        blast = bc[:, -1]
        s_new = (jnp.exp(blast)[..., None] * s
                 + jnp.einsum('bshk,bshv->bhkv', kc * jnp.exp(blast[:, None] - bc), vc))
        return s_new.astype(s.dtype), o

    s_fin, o = lax.scan(step, s0, (to_chunks(q), to_chunks(k), to_chunks(v), to_chunks(g)))
    return jnp.moveaxis(o, 0, 1).reshape(b, t, h, v.shape[-1]), s_fin


def bidir_scan(q, k, v, g, s):
    o_f, s_f = chunk_scan(q, k, v, g[:, :, 0], s[:, 0])
    flip = lambda a: jnp.flip(a, axis=1)
    o_b, s_b = chunk_scan(flip(q), flip(k), flip(v), flip(g[:, :, 1]), s[:, 1])
    return o_f + flip(o_b), jnp.stack([s_f, s_b], axis=1)


def even_project(h, w_in, q_norm, w_uq, kv_norm):
    b, t, _ = h.shape
    cq, ckv, krope, qd, kd, vd = jnp.split(h @ w_in, EVEN_CUTS, axis=-1)
    q = (rmsnorm(cq, q_norm) @ w_uq).reshape(b, t, H_A, NOPE_A + ROPE_A)
    return (q[..., :NOPE_A], q[..., NOPE_A:], rmsnorm(ckv, kv_norm), krope,
            qd.reshape(b, t, H_B, 2 * DH_B), kd.reshape(b, t, H_B, 2 * DH_B), vd.reshape(b, t, H_B, DV_B))


def even_mix(q_nope, q_rope, ckv, krope, qd, kd, vd, w_ukv, lam_p, subln, w_out, lam_init):
    b, tk = ckv.shape[:2]
    bq, tq = q_nope.shape[:2]
    kv = (ckv @ w_ukv).reshape(b, tk, H_A, NOPE_A + V_A)
    o_a = mla_attend(q_nope, q_rope, kv[..., :NOPE_A], krope, kv[..., NOPE_A:])
    lp = lam_p.astype(F32)
    lam = jnp.exp(jnp.sum(lp[0] * lp[1])) - jnp.exp(jnp.sum(lp[2] * lp[3])) + lam_init
    o_b = diff_attend(qd[..., :DH_B], qd[..., DH_B:], kd[..., :DH_B], kd[..., DH_B:], vd, lam)
    o_b = rmsnorm(o_b, subln) * (1.0 - lam_init)
    o = jnp.concatenate([o_a.reshape(bq, tq, H_A * V_A), o_b.reshape(bq, tq, H_B * DV_B)], axis=-1)
    return o @ w_out


def odd_project(h, w_in, w_gate, b_gate, ret_decay):
    b, t, _ = h.shape
    gq, gk, gv, glr, gr, rq, rk, rv, rr = jnp.split(h @ w_in, ODD_CUTS, axis=-1)
    logit = jnp.einsum('btdr,drk->btdk', glr.reshape(b, t, 2, GATE_RANK), w_gate) + b_gate
    g_gla = (jax.nn.log_sigmoid(logit) / GATE_TAU).reshape(b, t, 2, H_C, DK_C)
    log_gamma = jnp.log1p(-jnp.exp2(-ret_decay)).astype(h.dtype)
    g_ret = jnp.broadcast_to(log_gamma[None, None, :, :, None], (b, t, 2, H_D, 1))
    gla = (gq.reshape(b, t, H_C, DK_C) * DK_C ** -0.5, gk.reshape(b, t, H_C, DK_C),
           gv.reshape(b, t, H_C, DV_C), g_gla, gr)
    ret = (rq.reshape(b, t, H_D, DK_D), rk.reshape(b, t, H_D, DK_D) * DK_D ** -0.5,
           rv.reshape(b, t, H_D, DV_D), g_ret, rr)
    return gla, ret


def odd_mix(gla, ret, s_gla, s_ret, gla_norm, ret_norm, w_out):
    gq, gk, gv, g_gla, gr = gla
    rq, rk, rv, g_ret, rr = ret
    b, t = gq.shape[:2]
    o_c, s_gla_new = bidir_scan(gq, gk, gv, g_gla, s_gla)
    o_d, s_ret_new = bidir_scan(rq, rk, rv, g_ret, s_ret)
    o_c = rmsnorm(o_c, gla_norm).reshape(b, t, H_C * DV_C) * jax.nn.silu(gr)
    o_d = group_norm(o_d, ret_norm).reshape(b, t, H_D * DV_D) * jax.nn.silu(rr)
    return jnp.concatenate([o_c, o_d], axis=-1) @ w_out, s_gla_new, s_ret_new


def setup_inputs(seed: int = 0) -> dict:
    key = jax.random.key(seed)
    ks = iter(jax.random.split(key, 40))

    def nrm(shape, scale=1.0):
        return jax.random.normal(next(ks), shape, dtype=F32) * scale

    def gain(shape):
        return 1.0 + nrm(shape, 0.02)

    return {
        "x_prompt": nrm((BATCH, SEQ, D_MODEL)),
        "x_sample": nrm((DEC_BATCH, DEC_SEQ, D_MODEL)),
        "cache_mla_ckv": nrm((DEC_BATCH, N_EVEN, PAST_LEN, KV_LORA)),
        "cache_mla_krope": nrm((DEC_BATCH, N_EVEN, PAST_LEN, ROPE_A)),
        "cache_diff_k": nrm((DEC_BATCH, N_EVEN, PAST_LEN, H_B, 2 * DH_B)),
        "cache_diff_v": nrm((DEC_BATCH, N_EVEN, PAST_LEN, H_B, DV_B)),
        "state_gla": nrm((DEC_BATCH, N_ODD, 2, H_C, DK_C, DV_C)),
        "state_ret": nrm((DEC_BATCH, N_ODD, 2, H_D, DK_D, DV_D)),
        "c": nrm((DEC_BATCH, D_MODEL)),
        "c_ctx": nrm((D_MODEL,)),
        "mod_w": nrm((DEPTH, D_MODEL, N_MOD * D_MODEL), D_MODEL ** -0.5),
        "mod_b": nrm((DEPTH, N_MOD * D_MODEL), 0.02),
        "norm_g": gain((DEPTH, 3, D_MODEL)),
        "ffn_w_gate": nrm((DEPTH, 2, D_MODEL, D_FF), D_MODEL ** -0.5),
        "ffn_w_up": nrm((DEPTH, 2, D_MODEL, D_FF), D_MODEL ** -0.5),
        "ffn_w_down": nrm((DEPTH, 2, D_FF, D_MODEL), D_FF ** -0.5),
        "even_w_in": nrm((N_EVEN, D_MODEL, IN_EVEN), D_MODEL ** -0.5),
        "mla_q_norm": gain((N_EVEN, Q_LORA)),
        "mla_w_uq": nrm((N_EVEN, Q_LORA, H_A * (NOPE_A + ROPE_A)), Q_LORA ** -0.5),
        "mla_kv_norm": gain((N_EVEN, KV_LORA)),
        "mla_w_ukv": nrm((N_EVEN, KV_LORA, H_A * (NOPE_A + V_A)), KV_LORA ** -0.5),
        "diff_lambda": nrm((N_EVEN, 4, DH_B), 0.1),
        "diff_subln": gain((N_EVEN, DV_B)),
        "even_w_out": nrm((N_EVEN, MIX_EVEN, D_MODEL), MIX_EVEN ** -0.5),
        "odd_w_in": nrm((N_ODD, D_MODEL, IN_ODD), D_MODEL ** -0.5),
        "gla_w_gate": nrm((N_ODD, 2, GATE_RANK, H_C * DK_C), GATE_RANK ** -0.5),
        "gla_b_gate": nrm((N_ODD, 2, H_C * DK_C), 0.1),
        "gla_norm": gain((N_ODD, DV_C)),
        "ret_decay": 5.0 + jnp.arange(H_D, dtype=F32)[None, None, :] + nrm((N_ODD, 2, H_D), 0.1),
        "ret_norm": gain((N_ODD, DV_D)),
        "odd_w_out": nrm((N_ODD, MIX_ODD, D_MODEL), MIX_ODD ** -0.5),
        "final_g": gain((D_MODEL,)),
    }


def reference(x_prompt, x_sample, cache_mla_ckv, cache_mla_krope, cache_diff_k, cache_diff_v,
              state_gla, state_ret, c, c_ctx, mod_w, mod_b, norm_g, ffn_w_gate, ffn_w_up, ffn_w_down,
              even_w_in, mla_q_norm, mla_w_uq, mla_kv_norm, mla_w_ukv, diff_lambda, diff_subln, even_w_out,
              odd_w_in, gla_w_gate, gla_b_gate, gla_norm, ret_decay, ret_norm, odd_w_out, final_g):
    b_p, t_p, _ = x_prompt.shape
    b_s, t_s, _ = x_sample.shape
    rows = t_s // GRID_W
    row = jnp.repeat(jnp.arange(rows), GRID_W).astype(F32)
    col = jnp.tile(jnp.arange(GRID_W), rows).astype(F32)
    tpos = jnp.arange(t_s, dtype=F32)

    xp, xs = x_prompt, x_sample
    new_ckv, new_krope, new_dk, new_dv, new_sg, new_sr = [], [], [], [], [], []
    for l in range(DEPTH):
        mp = adaln(c_ctx[None].astype(x_prompt.dtype), mod_w[l], mod_b[l])
        ms = adaln(c, mod_w[l], mod_b[l])
        xp = ffn_half(xp, mp, 0, norm_g[l, 0], ffn_w_gate[l, 0], ffn_w_up[l, 0], ffn_w_down[l, 0])
        xs = ffn_half(xs, ms, 0, norm_g[l, 0], ffn_w_gate[l, 0], ffn_w_up[l, 0], ffn_w_down[l, 0])
        hp = modulate(xp, norm_g[l, 1], mp[:, :, 3], mp[:, :, 4])
        hs = modulate(xs, norm_g[l, 1], ms[:, :, 3], ms[:, :, 4])
        i = l // 2
        if l % 2 == 0:
            lam_init = 0.8 - 0.6 * math.exp(-0.3 * l)
            qn, qr, ckv, krope, qd, kd, vd = even_project(hp, even_w_in[i], mla_q_norm[i], mla_w_uq[i], mla_kv_norm[i])
            op = even_mix(qn, qr, ckv, krope, qd, kd, vd, mla_w_ukv[i], diff_lambda[i], diff_subln[i],
                          even_w_out[i], lam_init)
            new_ckv.append(ckv)
            new_krope.append(krope)
            new_dk.append(kd)
            new_dv.append(vd)
            qn, qr, ckv, krope, qd, kd, vd = even_project(hs, even_w_in[i], mla_q_norm[i], mla_w_uq[i], mla_kv_norm[i])
            qr = rope_2d(qr, row, col)
            krope = rope_2d(krope, row, col)
            qd = rope_2d(qd.reshape(b_s, t_s, H_B, 2, DH_B), row, col).reshape(b_s, t_s, H_B, 2 * DH_B)
            kd = rope_2d(kd.reshape(b_s, t_s, H_B, 2, DH_B), row, col).reshape(b_s, t_s, H_B, 2 * DH_B)
            os_ = even_mix(qn, qr,
                           jnp.concatenate([cache_mla_ckv[:, i], ckv], axis=1),
                           jnp.concatenate([cache_mla_krope[:, i], krope], axis=1),
                           qd,
                           jnp.concatenate([cache_diff_k[:, i], kd], axis=1),
                           jnp.concatenate([cache_diff_v[:, i], vd], axis=1),
                           mla_w_ukv[i], diff_lambda[i], diff_subln[i], even_w_out[i], lam_init)
        else:
            gla, ret = odd_project(hp, odd_w_in[i], gla_w_gate[i], gla_b_gate[i], ret_decay[i])
            s_gla0 = jnp.zeros((b_p, 2, H_C, DK_C, DV_C), dtype=hp.dtype)
            s_ret0 = jnp.zeros((b_p, 2, H_D, DK_D, DV_D), dtype=hp.dtype)
            op, sg, sr = odd_mix(gla, ret, s_gla0, s_ret0, gla_norm[i], ret_norm[i], odd_w_out[i])
            new_sg.append(sg)
            new_sr.append(sr)
            gla, ret = odd_project(hs, odd_w_in[i], gla_w_gate[i], gla_b_gate[i], ret_decay[i])
            rq, rk, rv, g_ret, rr = ret
            ret = (rope_1d(rq, tpos), rope_1d(rk, tpos), rv, g_ret, rr)
            os_, _, _ = odd_mix(gla, ret, state_gla[:, i], state_ret[:, i], gla_norm[i], ret_norm[i], odd_w_out[i])
        xp = xp + mp[:, :, 5] * op
        xs = xs + ms[:, :, 5] * os_
        xp = ffn_half(xp, mp, 6, norm_g[l, 2], ffn_w_gate[l, 1], ffn_w_up[l, 1], ffn_w_down[l, 1])
        xs = ffn_half(xs, ms, 6, norm_g[l, 2], ffn_w_gate[l, 1], ffn_w_up[l, 1], ffn_w_down[l, 1])

    y_prompt = rmsnorm(xp, final_g)
    y_sample = rmsnorm(xs, final_g)
    return (y_prompt, y_sample, jnp.stack(new_ckv, axis=1), jnp.stack(new_krope, axis=1),
            jnp.stack(new_dk, axis=1), jnp.stack(new_dv, axis=1),
            jnp.stack(new_sg, axis=1), jnp.stack(new_sr, axis=1))
```

```cpp
#include <hip/hip_runtime.h>
#include <hip/hip_cooperative_groups.h>
#include <cstdio>
#include <cstring>
namespace cg = cooperative_groups;

#define DI __device__ __forceinline__
typedef unsigned short u16;
typedef short bf16x8 __attribute__((ext_vector_type(8)));
typedef float f32x16 __attribute__((ext_vector_type(16)));
typedef __bf16 bf2_t __attribute__((ext_vector_type(2)));
typedef float f2_t __attribute__((ext_vector_type(2)));
typedef unsigned u32x4 __attribute__((ext_vector_type(4)));
typedef float f32x4 __attribute__((ext_vector_type(4)));
typedef unsigned u32x2 __attribute__((ext_vector_type(2)));
typedef float f32x2 __attribute__((ext_vector_type(2)));
#define MFMA(a, b, c) __builtin_amdgcn_mfma_f32_32x32x16_bf16((a), (b), (c), 0, 0, 0)

constexpr int M_ = 12288, MP_ = 4096;
constexpr int NTHR = 256;

constexpr size_t AL(size_t x) { return (x + 255) & ~(size_t)255; }
constexpr size_t OFF_XRES = 0;
constexpr size_t OFF_ACT = OFF_XRES + AL((size_t)M_ * 1024 * 4);
constexpr size_t OFF_ROWSQ = OFF_ACT + AL((size_t)M_ * 2816 * 2);
constexpr size_t OFF_MOD = OFF_ROWSQ + AL((size_t)13 * 16 * M_ * 4);
constexpr size_t OFF_CNT = OFF_MOD + AL((size_t)4 * 5 * 9216 * 4);
constexpr size_t OFF_BAR = OFF_CNT + 256;
constexpr size_t OFF_WGU = OFF_BAR + 16384;
constexpr size_t OFF_WD = OFF_WGU + AL((size_t)8 * 5632 * 1024 * 2);
constexpr size_t OFF_WINE = OFF_WD + AL((size_t)8 * 1024 * 2816 * 2);
constexpr size_t OFF_WUQ = OFF_WINE + AL((size_t)2 * 2304 * 1024 * 2);
constexpr size_t OFF_WUKV = OFF_WUQ + AL((size_t)2 * 768 * 384 * 2);
constexpr size_t OFF_WOUTE = OFF_WUKV + AL((size_t)2 * 1024 * 256 * 2);
constexpr size_t OFF_WINO = OFF_WOUTE + AL((size_t)2 * 1024 * 1024 * 2);
constexpr size_t OFF_WOUTO = OFF_WINO + AL((size_t)2 * 3200 * 1024 * 2);
constexpr size_t OFF_KD_L = OFF_WOUTO + AL((size_t)2 * 1024 * 1024 * 2);
constexpr size_t OFF_VDT_L = OFF_KD_L + AL((size_t)4 * 2 * 4 * 2560 * 128 * 2);
constexpr size_t OFF_KR_L = OFF_VDT_L + AL((size_t)4 * 2 * 4 * 2560 * 128 * 2);
constexpr size_t OFF_OMIX = OFF_KR_L + AL((size_t)4 * 2 * 2560 * 32 * 2);
constexpr size_t OFF_UNION = OFF_OMIX + AL((size_t)M_ * 1024 * 2);
constexpr size_t OFF_CQ = OFF_UNION;
constexpr size_t OFF_CKV = OFF_CQ + AL((size_t)M_ * 384 * 2);
constexpr size_t OFF_QA = OFF_CKV + AL((size_t)M_ * 256 * 2);
constexpr size_t OFF_QD = OFF_QA + AL((size_t)8 * M_ * 96 * 2);
constexpr size_t OFF_KN_P = OFF_QD + AL((size_t)4 * M_ * 128 * 2);
constexpr size_t OFF_KN_L = OFF_KN_P + AL((size_t)8 * 4096 * 64 * 2);
constexpr size_t OFF_VAT_P = OFF_KN_L + AL((size_t)4 * 8 * 2560 * 64 * 2);
constexpr size_t OFF_VAT_L = OFF_VAT_P + AL((size_t)16 * 8 * 64 * 256 * 2);
constexpr size_t OFF_KR_P = OFF_VAT_L + AL((size_t)4 * 8 * 64 * 2560 * 2);
constexpr size_t OFF_KD_P = OFF_KR_P + AL((size_t)4096 * 32 * 2);
constexpr size_t OFF_VDT_P = OFF_KD_P + AL((size_t)4 * 4096 * 128 * 2);
constexpr size_t OFF_EVEN_END = OFF_VDT_P + AL((size_t)16 * 4 * 128 * 256 * 2);
constexpr size_t OFF_GQ = OFF_UNION;
constexpr size_t OFF_GK = OFF_GQ + AL((size_t)M_ * 256 * 2);
constexpr size_t OFF_RQ = OFF_GK + AL((size_t)M_ * 256 * 2);
constexpr size_t OFF_RK = OFF_RQ + AL((size_t)M_ * 256 * 2);
constexpr size_t OFF_GV = OFF_RK + AL((size_t)M_ * 256 * 2);
constexpr size_t OFF_RV = OFF_GV + AL((size_t)M_ * 512 * 2);
constexpr size_t OFF_GATE = OFF_RV + AL((size_t)M_ * 512 * 2);
constexpr size_t OFF_GLR = OFF_GATE + AL((size_t)M_ * 1024 * 2);
constexpr size_t OFF_GG = OFF_GLR + AL((size_t)M_ * 32 * 4);
constexpr size_t OFF_ODD_END = OFF_GG + AL((size_t)M_ * 512 * 4);
constexpr size_t WS_TOTAL = OFF_EVEN_END > OFF_ODD_END ? OFF_EVEN_END : OFF_ODD_END;

constexpr size_t OUT_Y = 0;
constexpr size_t OUT_CKV = 12582912;
constexpr size_t OUT_KROPE = OUT_CKV + 2097152;
constexpr size_t OUT_DK = OUT_KROPE + 262144;
constexpr size_t OUT_DV = OUT_DK + 4194304;
constexpr size_t OUT_SG = OUT_DV + 4194304;
constexpr size_t OUT_SR = OUT_SG + 2097152;

struct Job {
  const float* src; u16* dst;
  int ld_src, col0, src_stride, cpu, row0, dst_stride, units, K, ld_dst, nrep, src_rep, dst_rep;
};
constexpr int MAXJOBS = 48;
struct Params {
  const float* in[32];
  float* out;
  char* ws;
  int njobs; int pad0;
  int cu[4][2][2];
  int cu_cache[2];
  Job jobs[MAXJOBS];
};

typedef const __attribute__((address_space(4))) Params* PP;

DI int tidx() { int t; asm volatile("v_mov_b32 %0, %1" : "=v"(t) : "v"(threadIdx.x)); return t; }
DI unsigned pack2(float a, float b) { f2_t v = {a, b}; bf2_t r = __builtin_convertvector(v, bf2_t); return __builtin_bit_cast(unsigned, r); }
DI u16 f2bf(float a) { return (u16)(pack2(a, 0.f) & 0xffffu); }
DI float bf2f(u16 v) { return __uint_as_float(((unsigned)v) << 16); }
DI float bflo(unsigned v) { return __uint_as_float(v << 16); }
DI float bfhi(unsigned v) { return __uint_as_float(v & 0xffff0000u); }
DI float tguard(float y) { asm volatile("s_nop 0" : "+v"(y)); return y; }
DI float silu_f(float x) { return x * tguard(__builtin_amdgcn_rcpf(1.f + tguard(__expf(-x)))); }
DI float logsigmoid_f(float x) { return fminf(x, 0.f) - log1pf(__expf(-fabsf(x))); }
DI int crow(int reg, int h) { return (reg & 3) + 8 * (reg >> 2) + 4 * h; }
DI void sincos_rev(float ang, float& s, float& c) {
  float rev = ang * 0.15915494309189535f; rev = rev - floorf(rev);
  s = __builtin_amdgcn_sinf(rev); c = __builtin_amdgcn_cosf(rev);
  asm volatile("s_nop 1" : "+v"(s), "+v"(c));
}
DI float fexp2(float x) { float y = __builtin_amdgcn_exp2f(x); asm volatile("s_nop 0" : "+v"(y)); return y; }
DI float fexp(float x) { float y = __builtin_amdgcn_exp2f(x * 1.4426950408889634f); asm volatile("s_nop 0" : "+v"(y)); return y; }
DI float wave_sum(float v) {
  v += __shfl_xor(v, 32); v += __shfl_xor(v, 16); v += __shfl_xor(v, 8); v += __shfl_xor(v, 4); v += __shfl_xor(v, 2); v += __shfl_xor(v, 1); return v;
}
DI float half_sum(float v) {
  v += __shfl_xor(v, 16); v += __shfl_xor(v, 8); v += __shfl_xor(v, 4); v += __shfl_xor(v, 2); v += __shfl_xor(v, 1); return v;
}
DI int cond_of_row(int row) { return row < MP_ ? 0 : 1 + ((row - MP_) >> 11); }

constexpr int LDT = 72;

struct ALBf16 {
  const u16* A; int lda; int m0; int tid;
  struct Regs { u32x4 v[4]; };
  DI void init(int m0_, char*, int tid_) { m0 = m0_; tid = tid_; }
  DI void load(int k0, Regs& R) {
    const u16* p = A + (size_t)(m0 + (tid >> 3)) * lda + k0 + (tid & 7) * 8;
#pragma unroll
    for (int i = 0; i < 4; ++i) R.v[i] = *(const u32x4*)(p + (size_t)i * 32 * lda);
  }
  DI void store(const Regs& R, u16* sA) {
#pragma unroll
    for (int i = 0; i < 4; ++i) *(u32x4*)(sA + ((tid >> 3) + 32 * i) * LDT + (tid & 7) * 8) = R.v[i];
  }
};

struct ALF32 {
  const float* A; int lda; int m0; int tid;
  struct Regs { f32x4 v[8]; };
  DI void init(int m0_, char*, int tid_) { m0 = m0_; tid = tid_; }
  DI void load(int k0, Regs& R) {
    const float* p = A + (size_t)(m0 + (tid >> 4)) * lda + k0 + (tid & 15) * 4;
#pragma unroll
    for (int i = 0; i < 8; ++i) R.v[i] = *(const f32x4*)(p + (size_t)i * 16 * lda);
  }
  DI void store(const Regs& R, u16* sA) {
#pragma unroll
    for (int i = 0; i < 8; ++i) {
      u32x2 o; o.x = pack2(R.v[i].x, R.v[i].y); o.y = pack2(R.v[i].z, R.v[i].w);
      *(u32x2*)(sA + ((tid >> 4) + 16 * i) * LDT + (tid & 15) * 4) = o;
    }
  }
};

struct ALBf16Norm {
  const u16* A; int lda; int K; const float* g; float* outn; size_t out_ld; int m0; int tid;
  float rstd[4];
  struct Regs { u32x4 v[4]; f32x4 g0, g1; };
  DI void init(int m0_, char* smem, int tid_) {
    m0 = m0_; tid = tid_;
    float* sR = (float*)smem;
    const int row = tid >> 1, hf = tid & 1;
    const int n8 = K / 16;
    const u16* p = A + (size_t)(m0 + row) * lda + hf * (K / 2);
    float ss = 0.f;
    for (int i = 0; i < n8; ++i) {
      u32x4 q = *(const u32x4*)(p + i * 8);
      float a;
      a = bflo(q.x); ss += a * a; a = bfhi(q.x); ss += a * a; a = bflo(q.y); ss += a * a; a = bfhi(q.y); ss += a * a;
      a = bflo(q.z); ss += a * a; a = bfhi(q.z); ss += a * a; a = bflo(q.w); ss += a * a; a = bfhi(q.w); ss += a * a;
    }
    ss += __shfl_xor(ss, 1);
    const float rs = tguard(rsqrtf(ss / (float)K + 1e-6f));
    __syncthreads();
    if (hf == 0) sR[row] = rs;
    if (outn) {
      float* op = outn + (size_t)row * out_ld + hf * (K / 2);
      const float* gp = g + hf * (K / 2);
      for (int i = 0; i < n8; ++i) {
        u32x4 q = *(const u32x4*)(p + i * 8);
        f32x4 ga = *(const f32x4*)(gp + i * 8), gb = *(const f32x4*)(gp + i * 8 + 4);
        f32x4 o0, o1;
        o0.x = bflo(q.x) * rs * ga.x; o0.y = bfhi(q.x) * rs * ga.y; o0.z = bflo(q.y) * rs * ga.z; o0.w = bfhi(q.y) * rs * ga.w;
        o1.x = bflo(q.z) * rs * gb.x; o1.y = bfhi(q.z) * rs * gb.y; o1.z = bflo(q.w) * rs * gb.z; o1.w = bfhi(q.w) * rs * gb.w;
        *(f32x4*)(op + i * 8) = o0; *(f32x4*)(op + i * 8 + 4) = o1;
      }
    }
    __syncthreads();
#pragma unroll
    for (int i = 0; i < 4; ++i) rstd[i] = sR[(tid >> 3) + 32 * i];
  }
  DI void load(int k0, Regs& R) {
    const int c = k0 + (tid & 7) * 8;
    const u16* p = A + (size_t)(m0 + (tid >> 3)) * lda + c;
#pragma unroll
    for (int i = 0; i < 4; ++i) R.v[i] = *(const u32x4*)(p + (size_t)i * 32 * lda);
    R.g0 = *(const f32x4*)(g + c); R.g1 = *(const f32x4*)(g + c + 4);
  }
  DI void store(const Regs& R, u16* sA) {
#pragma unroll
    for (int i = 0; i < 4; ++i) {
      const float r = rstd[i]; u32x4 q = R.v[i], o;
      o.x = pack2(bflo(q.x) * r * R.g0.x, bfhi(q.x) * r * R.g0.y);
      o.y = pack2(bflo(q.y) * r * R.g0.z, bfhi(q.y) * r * R.g0.w);
      o.z = pack2(bflo(q.z) * r * R.g1.x, bfhi(q.z) * r * R.g1.y);
      o.w = pack2(bflo(q.w) * r * R.g1.z, bfhi(q.w) * r * R.g1.w);
      *(u32x4*)(sA + ((tid >> 3) + 32 * i) * LDT + (tid & 7) * 8) = o;
    }
  }
};

constexpr int SMEM_BYTES = 4 * 128 * LDT * 2 + 64;
template <int NST, class ALT, class EPT>
DI void gemm_tile(ALT& al, const u16* __restrict__ Bt, int ldb, int K, int m0, int n0, EPT& ep, char* smem) {
  u16* sbuf = (u16*)smem;
  const int tid = tidx(), lane = tid & 63, w = tid >> 6, r = lane & 31, h = lane >> 5;
  const int wm = w >> 1, wn = w & 1;
  f32x16 acc[2][2];
#pragma unroll
  for (int i = 0; i < 2; ++i)
#pragma unroll
    for (int j = 0; j < 2; ++j)
#pragma unroll
      for (int e = 0; e < 16; ++e) acc[i][j][e] = 0.f;
  __syncthreads();
  al.init(m0, smem, tid);
  __syncthreads();
  typename ALT::Regs ra[3];
  u32x4 rb[2][4];
  const int brow = tid >> 3, bcol = (tid & 7) * 8;
  const u16* bp = Bt + (size_t)(n0 + brow) * ldb + bcol;
  const int KT = K >> 6;
  auto gloadA = [&](int kt, int slot) { al.load(kt * 64, ra[slot]); };
  auto gloadB = [&](int kt, int slot) {
#pragma unroll
    for (int i = 0; i < 4; ++i) rb[slot][i] = *(const u32x4*)(bp + (size_t)i * 32 * ldb + kt * 64);
  };
  auto lstore = [&](int slotA, int slotB, int buf) {
    u16* sA = sbuf + buf * (256 * LDT); u16* sB = sA + 128 * LDT;
    al.store(ra[slotA], sA);
#pragma unroll
    for (int i = 0; i < 4; ++i) *(u32x4*)(sB + (brow + 32 * i) * LDT + bcol) = rb[slotB][i];
  };
  auto compute = [&](int buf) {
    const u16* sA = sbuf + buf * (256 * LDT); const u16* sB = sA + 128 * LDT;
    const u16* pa = sA + (wm * 64 + r) * LDT + h * 8;
    const u16* pb = sB + (wn * 64 + r) * LDT + h * 8;
    bf16x8 fa[2][2], fb[2][2];
    fa[0][0] = *(const bf16x8*)(pa); fa[0][1] = *(const bf16x8*)(pa + 32 * LDT);
    fb[0][0] = *(const bf16x8*)(pb); fb[0][1] = *(const bf16x8*)(pb + 32 * LDT);
#pragma unroll
    for (int ks = 0; ks < 4; ++ks) {
      const int cur = ks & 1, nxt = cur ^ 1;
      if (ks < 3) {
        fa[nxt][0] = *(const bf16x8*)(pa + (ks + 1) * 16); fa[nxt][1] = *(const bf16x8*)(pa + 32 * LDT + (ks + 1) * 16);
        fb[nxt][0] = *(const bf16x8*)(pb + (ks + 1) * 16); fb[nxt][1] = *(const bf16x8*)(pb + 32 * LDT + (ks + 1) * 16);
      }
      __builtin_amdgcn_sched_barrier(0);
      acc[0][0] = MFMA(fa[cur][0], fb[cur][0], acc[0][0]);
      acc[0][1] = MFMA(fa[cur][0], fb[cur][1], acc[0][1]);
      acc[1][0] = MFMA(fa[cur][1], fb[cur][0], acc[1][0]);
      acc[1][1] = MFMA(fa[cur][1], fb[cur][1], acc[1][1]);
      __builtin_amdgcn_sched_barrier(0);
    }
  };
  gloadA(0, 0); gloadB(0, 0);
  if (KT > 1) { gloadA(1, 1); gloadB(1, 1); }
  if (KT > 2) gloadA(2, 2);
  lstore(0, 0, 0);
  if (KT > 2) gloadB(2, 0);
  if (KT > 3) gloadA(3, 0);
  __syncthreads();
  for (int kt0 = 0; kt0 < KT; kt0 += 6) {
#pragma unroll
    for (int u = 0; u < 6; ++u) {
      const int kt = kt0 + u;
      if (kt < KT) {
        if (kt + 1 < KT) {
          lstore((u + 1) % 3, (u + 1) & 1, (u + 1) & 1);
          if (kt + 3 < KT) gloadB(kt + 3, (u + 1) & 1);
          if (kt + 4 < KT) gloadA(kt + 4, (u + 1) % 3);
        }
        __builtin_amdgcn_sched_barrier(0);
        __builtin_amdgcn_s_setprio(2);
        compute(u & 1);
        __builtin_amdgcn_s_setprio(0);
        __syncthreads();
      }
    }
  }
  ep(acc, m0, n0);
}

struct EpiAct {
  u16* act;
  DI void operator()(f32x16 (&acc)[2][2], int m0, int n0) {
    const int tid_ = tidx(); const int lane = tid_ & 63, w = tid_ >> 6, r = lane & 31, h = lane >> 5, wm = w >> 1, wn = w & 1;
    const int col = (n0 >> 1) + wn * 32 + r;
#pragma unroll
    for (int i = 0; i < 2; ++i)
#pragma unroll
      for (int e = 0; e < 16; ++e) {
        const int row = m0 + wm * 64 + i * 32 + crow(e, h);
        act[(size_t)row * 2816 + col] = f2bf(silu_f(acc[i][0][e]) * acc[i][1][e]);
      }
  }
};

struct EpiResid {
  float* x; const float* gate; float coef; float* rowsq_next;
  DI void operator()(f32x16 (&acc)[2][2], int m0, int n0) {
    const int tid_ = tidx(); const int lane = tid_ & 63, w = tid_ >> 6, r = lane & 31, h = lane >> 5, wm = w >> 1, wn = w & 1;
    const int c0 = n0 + wn * 64 + r;
    const float g0 = gate[c0] * coef, g1 = gate[c0 + 32] * coef;
    float* xb = x + (size_t)(m0 + wm * 64) * 1024 + c0;
    float xa[2][16], xc[2][16];
#pragma unroll
    for (int i = 0; i < 2; ++i)
#pragma unroll
      for (int e = 0; e < 16; ++e) {
        const float* xp = xb + (size_t)(i * 32 + crow(e, h)) * 1024;
        xa[i][e] = xp[0]; xc[i][e] = xp[32];
      }
    __builtin_amdgcn_sched_barrier(0);
#pragma unroll
    for (int i = 0; i < 2; ++i) {
      float ssq[16];
#pragma unroll
      for (int e = 0; e < 16; ++e) {
        float* xp = xb + (size_t)(i * 32 + crow(e, h)) * 1024;
        const float a = xa[i][e] + g0 * acc[i][0][e];
        const float b = xc[i][e] + g1 * acc[i][1][e];
        xp[0] = a; xp[32] = b;
        ssq[e] = a * a + b * b;
      }
#pragma unroll
      for (int e = 0; e < 16; ++e) {
        const float sred = half_sum(ssq[e]);
        if (r == 0) rowsq_next[(size_t)((n0 >> 7) * 2 + wn) * M_ + m0 + wm * 64 + i * 32 + crow(e, h)] = sred;
      }
    }
  }
};

struct EpiEven {
  PP P; int li;
  DI void operator()(f32x16 (&acc)[2][2], int m0, int n0) {
    char* ws = P->ws; float* out = P->out;
    const int tid_ = tidx(); const int lane = tid_ & 63, w = tid_ >> 6, r = lane & 31, h = lane >> 5, wm = w >> 1, wn = w & 1;
    const int tn = n0 >> 7;
    const bool lat = m0 >= MP_;
    if (tn < 5) {
      u16* dst = tn < 3 ? (u16*)(ws + OFF_CQ) : (u16*)(ws + OFF_CKV);
      const int ld = tn < 3 ? 384 : 256;
      const int cb = (tn < 3 ? tn : tn - 3) * 128 + wn * 64 + r;
#pragma unroll
      for (int i = 0; i < 2; ++i)
#pragma unroll
        for (int j = 0; j < 2; ++j)
#pragma unroll
          for (int e = 0; e < 16; ++e) {
            const int row = m0 + wm * 64 + i * 32 + crow(e, h);
            dst[(size_t)row * ld + cb + j * 32] = f2bf(acc[i][j][e]);
          }
    } else if (tn < 13) {
      const bool isq = tn < 9;
      const int hh = isq ? tn - 5 : tn - 9;
      const float inv = exp2f(-(float)(r & 15) * (13.287712379549449f / 16.f));
      const bool first = (r & 16) == 0;
#pragma unroll
      for (int i = 0; i < 2; ++i)
#pragma unroll
        for (int j = 0; j < 2; ++j)
#pragma unroll
          for (int e = 0; e < 16; ++e) {
            const int row = m0 + wm * 64 + i * 32 + crow(e, h);
            float v = acc[i][j][e];
            const int c = wn * 64 + j * 32 + r;
            if (lat) {
              const int t = (row - MP_) & 2047;
              const float pos = (j == 0) ? (float)(t >> 6) : (float)(t & 63);
              float sn, cs; sincos_rev(pos * inv, sn, cs);
              const float pv = __shfl_xor(v, 16);
              v = first ? (v * cs - pv * sn) : (v * cs + pv * sn);
              const int b = (row - MP_) >> 11;
              if (isq) ((u16*)(ws + OFF_QD))[((size_t)hh * M_ + row) * 128 + c] = f2bf(v);
              else ((u16*)(ws + OFF_KD_L))[((size_t)((b * 2 + li) * 4 + hh) * 2560 + 512 + t) * 128 + c] = f2bf(v);
            } else {
              if (isq) ((u16*)(ws + OFF_QD))[((size_t)hh * M_ + row) * 128 + c] = f2bf(v);
              else {
                ((u16*)(ws + OFF_KD_P))[((size_t)hh * 4096 + row) * 128 + c] = f2bf(v);
                const int b = row >> 8, t = row & 255;
                out[OUT_DK + ((size_t)((b * 2 + li) * 256 + t) * 4 + hh) * 128 + c] = v;
              }
            }
          }
    } else if (tn < 17) {
      const int hh = tn - 13;
#pragma unroll
      for (int i = 0; i < 2; ++i)
#pragma unroll
        for (int j = 0; j < 2; ++j) {
          const int d = wn * 64 + j * 32 + r;
#pragma unroll
          for (int g = 0; g < 4; ++g) {
            const int row0 = m0 + wm * 64 + i * 32 + 8 * g + 4 * h;
            u32x2 pk; pk.x = pack2(acc[i][j][4 * g], acc[i][j][4 * g + 1]); pk.y = pack2(acc[i][j][4 * g + 2], acc[i][j][4 * g + 3]);
            if (lat) {
              const int b = (row0 - MP_) >> 11, t = (row0 - MP_) & 2047;
              *(u32x2*)((u16*)(ws + OFF_VDT_L) + ((size_t)((b * 2 + li) * 4 + hh) * 128 + d) * 2560 + 512 + t) = pk;
            } else {
              const int b = row0 >> 8, t = row0 & 255;
              *(u32x2*)((u16*)(ws + OFF_VDT_P) + ((size_t)(b * 4 + hh) * 128 + d) * 256 + t) = pk;
#pragma unroll
              for (int q = 0; q < 4; ++q)
                out[OUT_DV + ((size_t)((b * 2 + li) * 256 + t + q) * 4 + hh) * 128 + d] = acc[i][j][4 * g + q];
            }
          }
        }
    } else {
      if (wn == 0) {
        const float inv = exp2f(-(float)(r & 7) * (13.287712379549449f / 8.f));
        const bool first = (r & 8) == 0;
#pragma unroll
        for (int i = 0; i < 2; ++i)
#pragma unroll
          for (int e = 0; e < 16; ++e) {
            const int row = m0 + wm * 64 + i * 32 + crow(e, h);
            float v = acc[i][0][e];
            if (lat) {
              const int t = (row - MP_) & 2047, b = (row - MP_) >> 11;
              const float pos = (r < 16) ? (float)(t >> 6) : (float)(t & 63);
              float sn, cs; sincos_rev(pos * inv, sn, cs);
              const float pv = __shfl_xor(v, 8);
              v = first ? (v * cs - pv * sn) : (v * cs + pv * sn);
              ((u16*)(ws + OFF_KR_L))[((size_t)(b * 2 + li) * 2560 + 512 + t) * 32 + r] = f2bf(v);
            } else {
              ((u16*)(ws + OFF_KR_P))[(size_t)row * 32 + r] = f2bf(v);
              const int b = row >> 8, t = row & 255;
              out[OUT_KROPE + ((size_t)(b * 2 + li) * 256 + t) * 32 + r] = v;
            }
          }
      }
    }
  }
};

struct EpiUpQ {
  PP P;
  DI void operator()(f32x16 (&acc)[2][2], int m0, int n0) {
    u16* qa = (u16*)(P->ws + OFF_QA);
    const int tid_ = tidx(); const int lane = tid_ & 63, w = tid_ >> 6, r = lane & 31, h = lane >> 5, wm = w >> 1, wn = w & 1;
    const int tn = n0 >> 7;
    const bool lat = m0 >= MP_;
    if (tn < 4) {
      const int head = tn * 2 + wn;
#pragma unroll
      for (int i = 0; i < 2; ++i)
#pragma unroll
        for (int j = 0; j < 2; ++j)
#pragma unroll
          for (int e = 0; e < 16; ++e) {
            const int row = m0 + wm * 64 + i * 32 + crow(e, h);
            qa[((size_t)head * M_ + row) * 96 + j * 32 + r] = f2bf(acc[i][j][e]);
          }
    } else {
      const float inv = exp2f(-(float)(r & 7) * (13.287712379549449f / 8.f));
      const bool first = (r & 8) == 0;
#pragma unroll
      for (int i = 0; i < 2; ++i)
#pragma unroll
        for (int j = 0; j < 2; ++j) {
          const int head = (tn - 4) * 4 + wn * 2 + j;
#pragma unroll
          for (int e = 0; e < 16; ++e) {
            const int row = m0 + wm * 64 + i * 32 + crow(e, h);
            float v = acc[i][j][e];
            if (lat) {
              const int t = (row - MP_) & 2047;
              const float pos = (r < 16) ? (float)(t >> 6) : (float)(t & 63);
              float sn, cs; sincos_rev(pos * inv, sn, cs);
              const float pv = __shfl_xor(v, 8);
              v = first ? (v * cs - pv * sn) : (v * cs + pv * sn);
            }
            qa[((size_t)head * M_ + row) * 96 + 64 + r] = f2bf(v);
          }
        }
    }
  }
};

struct EpiUpKV {
  PP P;
  DI void operator()(f32x16 (&acc)[2][2], int m0, int n0) {
    char* ws = P->ws;
    const int tid_ = tidx(); const int lane = tid_ & 63, w = tid_ >> 6, r = lane & 31, h = lane >> 5, wm = w >> 1, wn = w & 1;
    const int head = n0 >> 7;
#pragma unroll
    for (int i = 0; i < 2; ++i)
#pragma unroll
      for (int j = 0; j < 2; ++j) {
        const int d = j * 32 + r;
#pragma unroll
        for (int g = 0; g < 4; ++g) {
          const int row0 = m0 + wm * 64 + i * 32 + 8 * g + 4 * h;
          bool isp; int b, key;
          if (row0 < MP_) { isp = true; b = row0 >> 8; key = row0 & 255; }
          else if (row0 < M_) { isp = false; b = (row0 - MP_) >> 11; key = 512 + ((row0 - MP_) & 2047); }
          else { isp = false; b = (row0 - M_) >> 9; key = (row0 - M_) & 511; }
          if (wn == 0) {
            u16* kp = isp ? (u16*)(ws + OFF_KN_P) + ((size_t)head * 4096 + b * 256 + key) * 64 + d
                          : (u16*)(ws + OFF_KN_L) + ((size_t)(b * 8 + head) * 2560 + key) * 64 + d;
#pragma unroll
            for (int q = 0; q < 4; ++q) kp[q * 64] = f2bf(acc[i][j][4 * g + q]);
          } else {
            u32x2 pk; pk.x = pack2(acc[i][j][4 * g], acc[i][j][4 * g + 1]); pk.y = pack2(acc[i][j][4 * g + 2], acc[i][j][4 * g + 3]);
            u16* vp = isp ? (u16*)(ws + OFF_VAT_P) + ((size_t)(b * 8 + head) * 64 + d) * 256 + key
                          : (u16*)(ws + OFF_VAT_L) + ((size_t)(b * 8 + head) * 64 + d) * 2560 + key;
            *(u32x2*)vp = pk;
          }
        }
      }
  }
};

struct EpiOdd {
  PP P;
  DI void operator()(f32x16 (&acc)[2][2], int m0, int n0) {
    char* ws = P->ws;
    const int tid_ = tidx(); const int lane = tid_ & 63, w = tid_ >> 6, r = lane & 31, h = lane >> 5, wm = w >> 1, wn = w & 1;
    const int tn = n0 >> 7;
    const bool lat = m0 >= MP_;
    if (tn == 24) {
      if (wn == 0) {
        float* glr = (float*)(ws + OFF_GLR);
#pragma unroll
        for (int i = 0; i < 2; ++i)
#pragma unroll
          for (int e = 0; e < 16; ++e) {
            const int row = m0 + wm * 64 + i * 32 + crow(e, h);
            glr[(size_t)row * 32 + r] = acc[i][0][e];
          }
      }
      return;
    }
    u16* dst; int ld, cb; float scl = 1.f; bool rope = false;
    if (tn < 2) { dst = (u16*)(ws + OFF_GQ); ld = 256; cb = tn * 128; scl = 0.125f; }
    else if (tn < 4) { dst = (u16*)(ws + OFF_GK); ld = 256; cb = (tn - 2) * 128; }
    else if (tn < 8) { dst = (u16*)(ws + OFF_GV); ld = 512; cb = (tn - 4) * 128; }
    else if (tn < 12) { dst = (u16*)(ws + OFF_GATE); ld = 1024; cb = (tn - 8) * 128; }
    else if (tn < 14) { dst = (u16*)(ws + OFF_RQ); ld = 256; cb = (tn - 12) * 128; rope = lat; }
    else if (tn < 16) { dst = (u16*)(ws + OFF_RK); ld = 256; cb = (tn - 14) * 128; scl = 0.125f; rope = lat; }
    else if (tn < 20) { dst = (u16*)(ws + OFF_RV); ld = 512; cb = (tn - 16) * 128; }
    else { dst = (u16*)(ws + OFF_GATE); ld = 1024; cb = 512 + (tn - 20) * 128; }
    const float inv = exp2f(-(float)r * (13.287712379549449f / 32.f));
#pragma unroll
    for (int i = 0; i < 2; ++i)
#pragma unroll
      for (int e = 0; e < 16; ++e) {
        const int row = m0 + wm * 64 + i * 32 + crow(e, h);
        float v0 = acc[i][0][e] * scl, v1 = acc[i][1][e] * scl;
        if (rope) {
          const int t = (row - MP_) & 2047;
          float sn, cs; sincos_rev((float)t * inv, sn, cs);
          const float a = v0 * cs - v1 * sn, b = v1 * cs + v0 * sn;
          v0 = a; v1 = b;
        }
        u16* p = dst + (size_t)row * ld + cb + wn * 64 + r;
        p[0] = f2bf(v0); p[32] = f2bf(v1);
      }
  }
};

DI void convert_range(PP P, char* smem, int ub, int ue, int first, int stride) {
  float* sT = (float*)smem;
  const int tid = tidx();
  const int c = tid & 63, kr = tid >> 6;
  const int kp = tid & 31, nr = tid >> 5;
  const float* csrc = nullptr; u16* cdst = nullptr; int cld_src = 0, cld_dst = 0, ccpu = 0;
  auto decode = [&](int u) {
    int j = 0, rem = u;
    for (;; ++j) { const int n = P->jobs[j].units * (P->jobs[j].K >> 6) * P->jobs[j].nrep; if (rem < n) break; rem -= n; }
    const auto& J = P->jobs[j];
    const int kts = J.K >> 6;
    const int kt = rem % kts; int t2 = rem / kts; const int un = t2 % J.units; const int rep = t2 / J.units;
    csrc = J.src + (size_t)rep * J.src_rep + (size_t)(kt * 64) * J.ld_src + J.col0 + un * J.src_stride;
    cdst = J.dst + (size_t)rep * J.dst_rep + (size_t)(J.row0 + un * J.dst_stride) * J.ld_dst + kt * 64;
    cld_src = J.ld_src; cld_dst = J.ld_dst; ccpu = J.cpu;
  };
  float v[16];
  const int u0 = ub + first;
  if (u0 < ue) {
    decode(u0);
#pragma unroll
    for (int kk = 0; kk < 16; ++kk) v[kk] = c < ccpu ? csrc[(size_t)(kk * 4 + kr) * cld_src + c] : 0.f;
  }
  for (int u = u0; u < ue; u += stride) {
    u16* dst = cdst; const int ld_dst = cld_dst, cpu = ccpu;
    __syncthreads();
#pragma unroll
    for (int kk = 0; kk < 16; ++kk) sT[(kk * 4 + kr) * 65 + c] = v[kk];
    __syncthreads();
    if (u + stride < ue) {
      decode(u + stride);
#pragma unroll
      for (int kk = 0; kk < 16; ++kk) v[kk] = c < ccpu ? csrc[(size_t)(kk * 4 + kr) * cld_src + c] : 0.f;
    }
#pragma unroll 4
    for (int nn = 0; nn < 8; ++nn) {
      const int n = nn * 8 + nr;
      if (n < cpu) *(unsigned*)(dst + (size_t)n * ld_dst + kp * 2) = pack2(sT[(2 * kp) * 65 + n], sT[(2 * kp + 1) * 65 + n]);
    }
  }
}

DI void phase_init(PP P, char* smem) {
  asm volatile("" : "+s"(P));
  char* ws = P->ws;
  const int tid = tidx(), lane = tid & 63, w = tid >> 6;
  const int nb = gridDim.x, bid = blockIdx.x;
  {
    float* rs = (float*)(ws + OFF_ROWSQ) + M_;
    for (int i = bid * NTHR + tid; i < 15 * M_; i += nb * NTHR) rs[i] = 0.f;
    if (bid == 0 && tid < 64) ((int*)(ws + OFF_CNT))[tid] = 0;
  }
  {
    float* xr = (float*)(ws + OFF_XRES); float* rs0 = (float*)(ws + OFF_ROWSQ);
    for (int row = bid * 4 + w; row < M_; row += nb * 4) {
      const float* src = row < MP_ ? P->in[0] + (size_t)row * 1024 : P->in[1] + (size_t)(row - MP_) * 1024;
      float ss = 0.f;
#pragma unroll
      for (int i = 0; i < 4; ++i) {
        f32x4 v = *(const f32x4*)(src + (i * 64 + lane) * 4);
        *(f32x4*)(xr + (size_t)row * 1024 + (i * 64 + lane) * 4) = v;
        ss += v.x * v.x + v.y * v.y + v.z * v.z + v.w * v.w;
      }
      ss = wave_sum(ss);
      if (lane == 0) rs0[row] = ss;
    }
  }
  {
    u16* kd = (u16*)(ws + OFF_KD_L);
    const int n4 = 4 * 2 * 512 * 4 * 128 / 4;
    for (int i4 = bid * NTHR + tid; i4 < n4; i4 += nb * NTHR) {
      const int e = i4 * 4;
      const int c = e & 127, hh = (e >> 7) & 3, key = (e >> 9) & 511, bi = e >> 18;
      f32x4 v = *(const f32x4*)(P->in[4] + e);
      u32x2 o; o.x = pack2(v.x, v.y); o.y = pack2(v.z, v.w);
      *(u32x2*)(kd + ((size_t)(bi * 4 + hh) * 2560 + key) * 128 + c) = o;
    }
    u16* kr = (u16*)(ws + OFF_KR_L);
    const int m4 = 4 * 2 * 512 * 32 / 4;
    for (int i4 = bid * NTHR + tid; i4 < m4; i4 += nb * NTHR) {
      const int e = i4 * 4;
      const int c = e & 31, key = (e >> 5) & 511, bi = e >> 14;
      f32x4 v = *(const f32x4*)(P->in[3] + e);
      u32x2 o; o.x = pack2(v.x, v.y); o.y = pack2(v.z, v.w);
      *(u32x2*)(kr + ((size_t)bi * 2560 + key) * 32 + c) = o;
    }
  }
  {
    float* sC = (float*)smem;
    float* sRed = sC + 5 * 1024;
    for (int i = tid; i < 5 * 1024; i += NTHR) {
      const float v = i < 1024 ? P->in[9][i] : P->in[8][i - 1024];
      sC[i] = silu_f(v);
    }
    __syncthreads();
    float* mod = (float*)(ws + OFF_MOD);
    float* sRed2 = sC + 5 * 1024;
    const int cg = tid & 15, kg = tid >> 4;
    for (int u = bid; u < 4 * 144; u += nb) {
      const int l = u / 144, n0 = (u % 144) * 64;
      const float* wp = P->in[10] + ((size_t)l * 1024 + kg * 64) * 9216 + n0 + cg * 4;
      f32x4 a0 = {0.f, 0.f, 0.f, 0.f}, a1 = a0, a2 = a0, a3 = a0, a4 = a0;
#pragma unroll 16
      for (int k = 0; k < 64; ++k) {
        const f32x4 wv = *(const f32x4*)(wp + (size_t)k * 9216);
        const int kk = kg * 64 + k;
        a0 += sC[kk] * wv; a1 += sC[1024 + kk] * wv; a2 += sC[2048 + kk] * wv; a3 += sC[3072 + kk] * wv; a4 += sC[4096 + kk] * wv;
      }
      *(f32x4*)(sRed2 + (kg * 5 + 0) * 64 + cg * 4) = a0; *(f32x4*)(sRed2 + (kg * 5 + 1) * 64 + cg * 4) = a1;
      *(f32x4*)(sRed2 + (kg * 5 + 2) * 64 + cg * 4) = a2; *(f32x4*)(sRed2 + (kg * 5 + 3) * 64 + cg * 4) = a3;
      *(f32x4*)(sRed2 + (kg * 5 + 4) * 64 + cg * 4) = a4;
      __syncthreads();
      for (int o = tid; o < 5 * 64; o += NTHR) {
        const int j = o >> 6, cc = o & 63;
        float sum = 0.f;
#pragma unroll
        for (int g = 0; g < 16; ++g) sum += sRed2[(g * 5 + j) * 64 + cc];
        mod[((size_t)l * 5 + j) * 9216 + n0 + cc] = sum + P->in[11][(size_t)l * 9216 + n0 + cc];
      }
      __syncthreads();
    }
  }
  __syncthreads();
  convert_range(P, smem, P->cu[0][0][0], P->cu[0][0][1], bid, nb);
  convert_range(P, smem, P->cu[0][1][0], P->cu[0][1][1], bid, nb);
  convert_range(P, smem, P->cu_cache[0], P->cu_cache[1], bid, nb);
}

template <int DQK, int DV, bool MLA>
DI void attn_pass(const u16* __restrict__ Q, int qstride, const u16* __restrict__ K, int kstride, const u16* __restrict__ KR,
                  const u16* __restrict__ VT, int Lk, float c_scale, f32x16 (&O)[DV / 32], char* smem) {
  constexpr int LDK = DQK + 8, CPR = DQK / 8, NKC = 64 * CPR / NTHR, NVC = DV * 8 / NTHR, NT = DV / 32;
  u16* sK = (u16*)smem;
  u16* sV = sK + 64 * 104;
  const int tid = tidx(), lane = tid & 63, w = tid >> 6, r = lane & 31, h = lane >> 5;
  bf16x8 qf[DQK / 16];
  {
    const u16* qp = Q + (size_t)(w * 32 + r) * qstride + h * 8;
#pragma unroll
    for (int ks = 0; ks < DQK / 16; ++ks) qf[ks] = *(const bf16x8*)(qp + ks * 16);
  }
#pragma unroll
  for (int t = 0; t < NT; ++t)
#pragma unroll
    for (int e = 0; e < 16; ++e) O[t][e] = 0.f;
  float m_run = -1e30f, l_part = 0.f;
  u32x4 kreg[NKC], vreg[NVC];
  auto gload = [&](int key0) {
#pragma unroll
    for (int p = 0; p < NKC; ++p) {
      const int id = tid + NTHR * p; const int key = id / CPR, c = id % CPR;
      if (MLA && c >= 8) kreg[p] = *(const u32x4*)(KR + (size_t)(key0 + key) * 32 + (c - 8) * 8);
      else kreg[p] = *(const u32x4*)(K + (size_t)(key0 + key) * kstride + c * 8);
    }
#pragma unroll
    for (int p = 0; p < NVC; ++p) {
      const int id = tid + NTHR * p; const int d = id >> 3, c = id & 7;
      vreg[p] = *(const u32x4*)(VT + (size_t)d * Lk + key0 + c * 8);
    }
  };
  gload(0);
  const int ntiles = Lk >> 6;
  for (int kt = 0; kt < ntiles; ++kt) {
    __syncthreads();
#pragma unroll
    for (int p = 0; p < NKC; ++p) { const int id = tid + NTHR * p; const int key = id / CPR, c = id % CPR; *(u32x4*)(sK + key * LDK + c * 8) = kreg[p]; }
#pragma unroll
    for (int p = 0; p < NVC; ++p) { const int id = tid + NTHR * p; const int d = id >> 3, c = id & 7; *(u32x4*)(sV + d * 72 + c * 8) = vreg[p]; }
    __syncthreads();
    if (kt + 1 < ntiles) gload((kt + 1) * 64);
    __builtin_amdgcn_sched_barrier(0);
    f32x16 S[2];
#pragma unroll
    for (int sub = 0; sub < 2; ++sub)
#pragma unroll
      for (int e = 0; e < 16; ++e) S[sub][e] = 0.f;
    {
      constexpr int NS = 2 * (DQK / 16);
      bf16x8 kf[2];
      kf[0] = *(const bf16x8*)(sK + r * LDK + h * 8);
#pragma unroll
      for (int st = 0; st < NS; ++st) {
        const int ks = st >> 1, sub = st & 1;
        if (st + 1 < NS) { const int ks1 = (st + 1) >> 1, sub1 = (st + 1) & 1; kf[(st + 1) & 1] = *(const bf16x8*)(sK + (sub1 * 32 + r) * LDK + ks1 * 16 + h * 8); }
        __builtin_amdgcn_sched_barrier(0);
        S[sub] = MFMA(kf[st & 1], qf[ks], S[sub]);
        __builtin_amdgcn_sched_barrier(0);
      }
    }
    union VF { u32x2 u[2]; bf16x8 v; };
    VF vf[2][NT];
#pragma unroll
    for (int t = 0; t < NT; ++t) {
      const u16* vp = sV + (t * 32 + r) * 72 + 4 * h;
      vf[0][t].u[0] = *(const u32x2*)vp; vf[0][t].u[1] = *(const u32x2*)(vp + 8);
    }
    float mx = S[0][0];
#pragma unroll
    for (int e = 0; e < 16; ++e) { mx = fmaxf(mx, S[0][e]); mx = fmaxf(mx, S[1][e]); }
    mx = fmaxf(mx, __shfl_xor(mx, 32));
    const float m_new = fmaxf(m_run, mx * c_scale);
    const float alpha = fexp2(m_run - m_new);
    m_run = m_new;
    float ls = 0.f;
#pragma unroll
    for (int sub = 0; sub < 2; ++sub)
#pragma unroll
      for (int e = 0; e < 16; ++e) { const float p = fexp2(S[sub][e] * c_scale - m_new); S[sub][e] = p; ls += p; }
    l_part = l_part * alpha + ls;
#pragma unroll
    for (int t = 0; t < NT; ++t)
#pragma unroll
      for (int e = 0; e < 16; ++e) O[t][e] *= alpha;
#pragma unroll
    for (int g = 0; g < 4; ++g) {
      const int sub = g >> 1, s2 = g & 1;
      if (g < 3) {
        const int sub1 = (g + 1) >> 1, s21 = (g + 1) & 1;
#pragma unroll
        for (int t = 0; t < NT; ++t) {
          const u16* vp = sV + (t * 32 + r) * 72 + sub1 * 32 + 16 * s21 + 4 * h;
          vf[(g + 1) & 1][t].u[0] = *(const u32x2*)vp; vf[(g + 1) & 1][t].u[1] = *(const u32x2*)(vp + 8);
        }
      }
      union { unsigned u[4]; bf16x8 v; } pf;
#pragma unroll
      for (int q = 0; q < 4; ++q) pf.u[q] = pack2(S[sub][8 * s2 + 2 * q], S[sub][8 * s2 + 2 * q + 1]);
      __builtin_amdgcn_sched_barrier(0);
#pragma unroll
      for (int t = 0; t < NT; ++t) O[t] = MFMA(vf[g & 1][t].v, pf.v, O[t]);
      __builtin_amdgcn_sched_barrier(0);
    }
  }
  const float l = l_part + __shfl_xor(l_part, 32);
  const float il = 1.f / l;
#pragma unroll
  for (int t = 0; t < NT; ++t)
#pragma unroll
    for (int e = 0; e < 16; ++e) O[t][e] *= il;
}

DI void phase_attn(PP P, int l, char* smem, int cidx) {
  asm volatile("" : "+s"(P));
  char* ws = P->ws;
  const int li = l >> 1;
  const int tid = tidx(), lane = tid & 63, w = tid >> 6, r = lane & 31, h = lane >> 5;
  int* cnt = (int*)(ws + OFF_CNT) + cidx;
  int* sItem = (int*)(smem + 48 * 1024);
  const float lam_init = 0.8f - 0.6f * __expf(-0.3f * (float)l);
  float lam;
  {
    const float* lp = P->in[21] + (size_t)li * 4 * 64;
    const float a = wave_sum(lp[lane] * lp[64 + lane]);
    const float b = wave_sum(lp[128 + lane] * lp[192 + lane]);
    lam = __expf(a) - __expf(b) + lam_init;
  }
  u16* omix = (u16*)(ws + OFF_OMIX);
  float* stash = (float*)(ws + OFF_ACT) + (size_t)blockIdx.x * (64 * NTHR);
  const float LOG2E = 1.4426950408889634f;
  for (;;) {
    __syncthreads();
    if (tid == 0) *sItem = atomicAdd(cnt, 1);
    __syncthreads();
    const int item = *sItem;
    if (item >= 1152) break;
    bool lat, diff; int b, hd, qb;
    if (item < 256) { lat = true; diff = true; b = item >> 6; hd = (item >> 4) & 3; qb = item & 15; }
    else if (item < 768) { const int it = item - 256; lat = true; diff = false; b = it >> 7; hd = (it >> 4) & 7; qb = it & 15; }
    else if (item < 896) { const int it = item - 768; lat = false; diff = true; b = it >> 3; hd = (it >> 1) & 3; qb = it & 1; }
    else { const int it = item - 896; lat = false; diff = false; b = it >> 4; hd = (it >> 1) & 7; qb = it & 1; }
    const int row0 = lat ? MP_ + b * 2048 + qb * 128 : b * 256 + qb * 128;
    const int Lk = lat ? 2560 : 256;
    if (!diff) {
#ifndef NO_MLA
      const u16* Q = (const u16*)(ws + OFF_QA) + ((size_t)hd * M_ + row0) * 96;
      const u16* K = lat ? (const u16*)(ws + OFF_KN_L) + (size_t)(b * 8 + hd) * 2560 * 64 : (const u16*)(ws + OFF_KN_P) + ((size_t)hd * 4096 + b * 256) * 64;
      const u16* KR = lat ? (const u16*)(ws + OFF_KR_L) + (size_t)(b * 2 + li) * 2560 * 32 : (const u16*)(ws + OFF_KR_P) + (size_t)(b * 256) * 32;
      const u16* VT = lat ? (const u16*)(ws + OFF_VAT_L) + (size_t)(b * 8 + hd) * 64 * 2560 : (const u16*)(ws + OFF_VAT_P) + (size_t)(b * 8 + hd) * 64 * 256;
      f32x16 O[2];
      attn_pass<96, 64, true>(Q, 96, K, 64, KR, VT, Lk, 0.10206207261596575f * LOG2E, O, smem);
      u16* op = omix + (size_t)(row0 + w * 32 + r) * 1024 + hd * 64;
#pragma unroll
      for (int t = 0; t < 2; ++t)
#pragma unroll
        for (int g = 0; g < 4; ++g) {
          u32x2 pk; pk.x = pack2(O[t][4 * g], O[t][4 * g + 1]); pk.y = pack2(O[t][4 * g + 2], O[t][4 * g + 3]);
          *(u32x2*)(op + t * 32 + 8 * g + 4 * h) = pk;
        }
#endif
    } else {
#ifndef NO_DIFF
      const u16* Q = (const u16*)(ws + OFF_QD) + ((size_t)hd * M_ + row0) * 128;
      const u16* K = lat ? (const u16*)(ws + OFF_KD_L) + (size_t)((b * 2 + li) * 4 + hd) * 2560 * 128 : (const u16*)(ws + OFF_KD_P) + ((size_t)hd * 4096 + b * 256) * 128;
      const u16* VT = lat ? (const u16*)(ws + OFF_VDT_L) + (size_t)((b * 2 + li) * 4 + hd) * 128 * 2560 : (const u16*)(ws + OFF_VDT_P) + (size_t)(b * 4 + hd) * 128 * 256;
      f32x16 O[4];
      float ss = 0.f;
      float* st = stash + tid * 64;
#pragma unroll 1
      for (int pass = 0; pass < 2; ++pass) {
        attn_pass<64, 128, false>(Q + pass * 64, 128, K + pass * 64, 128, nullptr, VT, Lk, 0.125f * LOG2E, O, smem);
        if (pass == 0) {
#pragma unroll
          for (int t = 0; t < 4; ++t)
#pragma unroll
            for (int g = 0; g < 4; ++g) {
              f32x4 v; v.x = O[t][4 * g]; v.y = O[t][4 * g + 1]; v.z = O[t][4 * g + 2]; v.w = O[t][4 * g + 3];
              *(f32x4*)(st + t * 16 + 4 * g) = v;
            }
        }
      }
#pragma unroll
      for (int t = 0; t < 4; ++t) {
#pragma unroll
        for (int g = 0; g < 4; ++g) {
          const f32x4 v = *(const f32x4*)(st + t * 16 + 4 * g);
          O[t][4 * g] = v.x - lam * O[t][4 * g]; O[t][4 * g + 1] = v.y - lam * O[t][4 * g + 1];
          O[t][4 * g + 2] = v.z - lam * O[t][4 * g + 2]; O[t][4 * g + 3] = v.w - lam * O[t][4 * g + 3];
          ss += O[t][4 * g] * O[t][4 * g] + O[t][4 * g + 1] * O[t][4 * g + 1] + O[t][4 * g + 2] * O[t][4 * g + 2] + O[t][4 * g + 3] * O[t][4 * g + 3];
        }
        __builtin_amdgcn_sched_barrier(0);
      }
      ss += __shfl_xor(ss, 32);
      const float rs = tguard(rsqrtf(ss * (1.f / 128.f) + 1e-6f)) * (1.f - lam_init);
      const float* sg = P->in[22] + (size_t)li * 128;
      u16* op = omix + (size_t)(row0 + w * 32 + r) * 1024 + 512 + hd * 128;
#pragma unroll
      for (int t = 0; t < 4; ++t)
#pragma unroll
        for (int g = 0; g < 4; ++g) {
          const int d = t * 32 + 8 * g + 4 * h;
          const f32x4 gv = *(const f32x4*)(sg + d);
          u32x2 pk; pk.x = pack2(O[t][4 * g] * rs * gv.x, O[t][4 * g + 1] * rs * gv.y); pk.y = pack2(O[t][4 * g + 2] * rs * gv.z, O[t][4 * g + 3] * rs * gv.w);
          *(u32x2*)(op + d) = pk;
        }
#endif
    }
  }
}

DI void phase_gateprep(PP P, int l) {
  asm volatile("" : "+s"(P));
  char* ws = P->ws;
  const int li = l >> 1;
  const int d = tidx();
  const float* glr = (const float*)(ws + OFF_GLR);
  float* gg = (float*)(ws + OFF_GG);
  const int dir = blockIdx.x & 1;
  float wg[16];
  const float* wp = P->in[25] + ((size_t)(li * 2 + dir) * 16) * 256 + d;
#pragma unroll
  for (int q = 0; q < 16; ++q) wg[q] = wp[q * 256];
  const float bg = P->in[26][(size_t)(li * 2 + dir) * 256 + d];
  const int rstep = gridDim.x >> 1;
  for (int row0 = blockIdx.x >> 1; row0 < M_; row0 += 4 * rstep) {
    f32x4 gq[4][4];
#pragma unroll
    for (int u = 0; u < 4; ++u) {
      const int row = row0 + u * rstep;
      if (row < M_) {
        const f32x4* gp = (const f32x4*)(glr + (size_t)row * 32 + dir * 16);
        gq[u][0] = gp[0]; gq[u][1] = gp[1]; gq[u][2] = gp[2]; gq[u][3] = gp[3];
      }
    }
    __builtin_amdgcn_sched_barrier(0);
#pragma unroll
    for (int u = 0; u < 4; ++u) {
      const int row = row0 + u * rstep;
      if (row < M_) {
        const f32x4 g0 = gq[u][0], g1 = gq[u][1], g2 = gq[u][2], g3 = gq[u][3];
        const float lg = bg + g0.x * wg[0] + g0.y * wg[1] + g0.z * wg[2] + g0.w * wg[3] + g1.x * wg[4] + g1.y * wg[5] + g1.z * wg[6] + g1.w * wg[7]
                         + g2.x * wg[8] + g2.y * wg[9] + g2.z * wg[10] + g2.w * wg[11] + g3.x * wg[12] + g3.y * wg[13] + g3.z * wg[14] + g3.w * wg[15];
        gg[(size_t)row * 512 + dir * 256 + d] = logsigmoid_f(lg) * (1.f / 16.f);
      }
    }
  }
}

DI void phase_scan(PP P, int l, char* smem, int cidx) {
  asm volatile("" : "+s"(P));
  char* ws = P->ws; float* out = P->out;
  const int li = l >> 1;
  const int tid = tidx(), lane = tid & 63, w = tid >> 6, r = lane & 31, h = lane >> 5;
  u16* sQ = (u16*)smem;
  u16* sK = sQ + 64 * LDT;
  u16* sKT = sK + 64 * LDT;
  u16* sVT = sKT + 64 * LDT;
  u16* sS = sVT + 64 * LDT;
  float* sSeg = (float*)(sS + 64 * LDT);
  float* sTot = sSeg + 256;
  int* sItem = (int*)(sTot + 64);
  int* cnt = (int*)(ws + OFF_CNT) + cidx;
  const int tt = w & 1, vt = w >> 1;
  for (;;) {
    __syncthreads();
    if (tid == 0) *sItem = atomicAdd(cnt, 1);
    __syncthreads();
    const int item = *sItem;
    if (item >= 640) break;
    bool lat; int mx, b, hd, dir, vh;
    if (item < 128) { lat = true; vh = item & 1; dir = (item >> 1) & 1; hd = (item >> 2) & 3; b = (item >> 4) & 3; mx = item >> 6; }
    else { const int it = item - 128; lat = false; vh = it & 1; dir = (it >> 1) & 1; hd = (it >> 2) & 3; b = (it >> 4) & 15; mx = it >> 8; }
    const int T = lat ? 2048 : 256, NC = T >> 6;
    const int rb = lat ? MP_ + b * 2048 : b * 256;
    const u16* Qg = (const u16*)(ws + (mx ? OFF_RQ : OFF_GQ));
    const u16* Kg = (const u16*)(ws + (mx ? OFF_RK : OFF_GK));
    const u16* Vg = (const u16*)(ws + (mx ? OFF_RV : OFF_GV));
    u16* ob = (u16*)(ws + OFF_ACT) + (size_t)dir * M_ * 1024;
    const int d = tid & 63, part = tid >> 6;
    const float* gg = (const float*)(ws + OFF_GG) + dir * 256 + hd * 64 + d;
    float lgam = 0.f;
    if (mx) lgam = log1pf(-exp2f(-P->in[28][(li * 2 + dir) * 4 + hd]));
    f32x16 St;
    if (lat) {
      const float* sp = P->in[mx ? 7 : 6] + ((size_t)((b * 2 + li) * 2 + dir) * 4 + hd) * 8192 + (size_t)(tt * 32 + r) * 128 + vh * 64 + vt * 32;
#pragma unroll
      for (int g = 0; g < 4; ++g) {
        const f32x4 v = *(const f32x4*)(sp + 8 * g + 4 * h);
        St[4 * g] = v.x; St[4 * g + 1] = v.y; St[4 * g + 2] = v.z; St[4 * g + 3] = v.w;
      }
    } else {
#pragma unroll
      for (int e = 0; e < 16; ++e) St[e] = 0.f;
    }
    u16 rq[16], rk[16], rv[16]; float rg[16];
    auto issue = [&](int c) {
#pragma unroll
      for (int j = 0; j < 16; ++j) {
        const int t = part * 16 + j;
        const int tok = dir == 0 ? c * 64 + t : T - 1 - (c * 64 + t);
        const int row = rb + tok;
        rq[j] = Qg[(size_t)row * 256 + hd * 64 + d];
        rk[j] = Kg[(size_t)row * 256 + hd * 64 + d];
        rv[j] = Vg[(size_t)row * 512 + hd * 128 + vh * 64 + d];
        rg[j] = mx == 0 ? gg[(size_t)row * 512] : lgam;
      }
    };
    issue(0);
    for (int c = 0; c < NC; ++c) {
#pragma unroll
      for (int e = 0; e < 16; ++e) sS[(vt * 32 + crow(e, h)) * LDT + tt * 32 + r] = f2bf(St[e]);
      float qv[16], kv[16], cum[16];
      float run = 0.f;
#pragma unroll
      for (int j = 0; j < 16; ++j) {
        const int t = part * 16 + j;
        qv[j] = bf2f(rq[j]);
        kv[j] = bf2f(rk[j]);
        run += rg[j]; cum[j] = run;
        sVT[d * LDT + t] = rv[j];
      }
      sSeg[part * 64 + d] = run;
      __syncthreads();
      float off = 0.f, tot = 0.f;
#pragma unroll
      for (int p = 0; p < 4; ++p) { const float s = sSeg[p * 64 + d]; tot += s; if (p < part) off += s; }
      if (part == 0) sTot[d] = fexp(tot);
#pragma unroll
      for (int j = 0; j < 16; ++j) {
        const int t = part * 16 + j;
        const float bc = cum[j] + off;
        sQ[t * LDT + d] = f2bf(qv[j] * fexp(bc));
        sK[t * LDT + d] = f2bf(kv[j] * fexp(-bc));
        sKT[d * LDT + t] = f2bf(kv[j] * fexp(tot - bc));
      }
      __syncthreads();
      if (c + 1 < NC) issue(c + 1);
      __builtin_amdgcn_sched_barrier(0);
      bf16x8 qf[4];
#pragma unroll
      for (int ks = 0; ks < 4; ++ks) qf[ks] = *(const bf16x8*)(sQ + (tt * 32 + r) * LDT + ks * 16 + h * 8);
      f32x16 Ot;
#pragma unroll
      for (int e = 0; e < 16; ++e) Ot[e] = 0.f;
#pragma unroll
      for (int ks = 0; ks < 4; ++ks) {
        const bf16x8 a = *(const bf16x8*)(sS + (vt * 32 + r) * LDT + ks * 16 + h * 8);
        Ot = MFMA(a, qf[ks], Ot);
      }
      for (int st = 0; st <= tt; ++st) {
        f32x16 At;
#pragma unroll
        for (int e = 0; e < 16; ++e) At[e] = 0.f;
#pragma unroll
        for (int ks = 0; ks < 4; ++ks) {
          const bf16x8 a = *(const bf16x8*)(sK + (st * 32 + r) * LDT + ks * 16 + h * 8);
          At = MFMA(a, qf[ks], At);
        }
        if (st == tt) {
#pragma unroll
          for (int e = 0; e < 16; ++e) if (crow(e, h) > r) At[e] = 0.f;
        }
#pragma unroll
        for (int s2 = 0; s2 < 2; ++s2) {
          union { unsigned u[4]; bf16x8 v; } pf;
#pragma unroll
          for (int q = 0; q < 4; ++q) pf.u[q] = pack2(At[8 * s2 + 2 * q], At[8 * s2 + 2 * q + 1]);
          const u16* vp = sVT + (vt * 32 + r) * LDT + st * 32 + 16 * s2 + 4 * h;
          union { u32x2 u[2]; bf16x8 v; } vf;
          vf.u[0] = *(const u32x2*)vp; vf.u[1] = *(const u32x2*)(vp + 8);
          Ot = MFMA(vf.v, pf.v, Ot);
        }
      }
      {
        const int t = tt * 32 + r;
        const int tok = dir == 0 ? c * 64 + t : T - 1 - (c * 64 + t);
        u16* op = ob + (size_t)(rb + tok) * 1024 + mx * 512 + hd * 128 + vh * 64 + vt * 32;
#pragma unroll
        for (int g = 0; g < 4; ++g) {
          u32x2 pk; pk.x = pack2(Ot[4 * g], Ot[4 * g + 1]); pk.y = pack2(Ot[4 * g + 2], Ot[4 * g + 3]);
          *(u32x2*)(op + 8 * g + 4 * h) = pk;
        }
      }
      {
        const float dec = sTot[tt * 32 + r];
#pragma unroll
        for (int e = 0; e < 16; ++e) St[e] *= dec;
#pragma unroll
        for (int ks = 0; ks < 4; ++ks) {
          const bf16x8 a = *(const bf16x8*)(sVT + (vt * 32 + r) * LDT + ks * 16 + h * 8);
          const bf16x8 bb = *(const bf16x8*)(sKT + (tt * 32 + r) * LDT + ks * 16 + h * 8);
          St = MFMA(a, bb, St);
        }
      }
      __syncthreads();
    }
    if (!lat) {
      float* op = out + (mx ? OUT_SR : OUT_SG) + ((size_t)((b * 2 + li) * 2 + dir) * 4 + hd) * 8192 + (size_t)(tt * 32 + r) * 128 + vh * 64 + vt * 32;
#pragma unroll
      for (int g = 0; g < 4; ++g) {
        f32x4 v; v.x = St[4 * g]; v.y = St[4 * g + 1]; v.z = St[4 * g + 2]; v.w = St[4 * g + 3];
        *(f32x4*)(op + 8 * g + 4 * h) = v;
      }
    }
  }
}

DI void phase_combine(PP P, int l) {
  asm volatile("" : "+s"(P));
  char* ws = P->ws;
  const int li = l >> 1;
  const int tid_ = tidx(); const int lane = tid_ & 63, w = tid_ >> 6;
  const unsigned* of = (const unsigned*)(ws + OFF_ACT);
  const unsigned* obk = of + (size_t)M_ * 512;
  const unsigned* gate = (const unsigned*)(ws + OFF_GATE);
  unsigned* omix = (unsigned*)(ws + OFF_OMIX);
  const f32x2 gn = *(const f32x2*)(P->in[27] + (size_t)li * 128 + 2 * lane);
  const f32x2 rn = *(const f32x2*)(P->in[29] + (size_t)li * 128 + 2 * lane);
  for (int row = blockIdx.x * 4 + w; row < M_; row += gridDim.x * 4) {
    unsigned av[8], bv[8], gv[8];
#pragma unroll
    for (int mh = 0; mh < 8; ++mh) { const size_t idx = (size_t)row * 512 + mh * 64 + lane; av[mh] = of[idx]; bv[mh] = obk[idx]; gv[mh] = gate[idx]; }
    __builtin_amdgcn_sched_barrier(0);
#pragma unroll
    for (int mh = 0; mh < 8; ++mh) {
      const size_t idx = (size_t)row * 512 + mh * 64 + lane;
      const unsigned a = av[mh], b = bv[mh], gt = gv[mh];
      float o0 = bflo(a) + bflo(b), o1 = bfhi(a) + bfhi(b);
      float y0, y1;
      if (mh < 4) {
        const float ss = wave_sum(o0 * o0 + o1 * o1);
        const float rs = tguard(rsqrtf(ss * (1.f / 128.f) + 1e-6f));
        y0 = o0 * rs * gn.x; y1 = o1 * rs * gn.y;
      } else {
        const float mu = wave_sum(o0 + o1) * (1.f / 128.f);
        const float d0 = o0 - mu, d1 = o1 - mu;
        const float var = wave_sum(d0 * d0 + d1 * d1) * (1.f / 128.f);
        const float rs = tguard(rsqrtf(var + 1e-6f));
        y0 = d0 * rs * rn.x; y1 = d1 * rs * rn.y;
      }
      y0 *= silu_f(bflo(gt)); y1 *= silu_f(bfhi(gt));
      omix[idx] = pack2(y0, y1);
    }
  }
}

DI void phase_final(PP P) {
  asm volatile("" : "+s"(P));
  char* ws = P->ws;
  const int tid_ = tidx(); const int lane = tid_ & 63, w = tid_ >> 6;
  const float* xr = (const float*)(ws + OFF_XRES);
  const float* rs = (const float*)(ws + OFF_ROWSQ) + (size_t)12 * 16 * M_;
  for (int row = blockIdx.x * 4 + w; row < M_; row += gridDim.x * 4) {
    float ssum = 0.f;
#pragma unroll
    for (int i = 0; i < 16; ++i) ssum += rs[(size_t)i * M_ + row];
    const float rstd = tguard(rsqrtf(ssum * (1.f / 1024.f) + 1e-6f));
#pragma unroll
    for (int i = 0; i < 4; ++i) {
      const int c = (i * 64 + lane) * 4;
      f32x4 v = *(const f32x4*)(xr + (size_t)row * 1024 + c);
      const f32x4 g = *(const f32x4*)(P->in[31] + c);
      v.x *= rstd * g.x; v.y *= rstd * g.y; v.z *= rstd * g.z; v.w *= rstd * g.w;
      *(f32x4*)(P->out + OUT_Y + (size_t)row * 1024 + c) = v;
    }
  }
}

DI void phase_hprep(PP P, int l, int sidx) {
  asm volatile("" : "+s"(P));
  char* ws = P->ws;
  const int tid_ = tidx(); const int lane = tid_ & 63, w = tid_ >> 6;
  const float* xr = (const float*)(ws + OFF_XRES);
  const float* rs = (const float*)(ws + OFF_ROWSQ) + (size_t)(l * 3 + sidx) * 16 * M_;
  const float* g = P->in[12] + (size_t)(l * 3 + sidx) * 1024;
  u16* H = (u16*)(ws + OFF_OMIX);
  for (int row = blockIdx.x * 4 + w; row < M_; row += gridDim.x * 4) {
    float ssum = 0.f;
#pragma unroll
    for (int i = 0; i < 16; ++i) ssum += rs[(size_t)i * M_ + row];
    const float rstd = tguard(rsqrtf(ssum * (1.f / 1024.f) + 1e-6f));
    const float* modp = (const float*)(ws + OFF_MOD) + ((size_t)(l * 5 + cond_of_row(row)) * 9 + sidx * 3) * 1024;
#pragma unroll
    for (int i = 0; i < 4; ++i) {
      const int c = (i * 64 + lane) * 4;
      const f32x4 v = *(const f32x4*)(xr + (size_t)row * 1024 + c);
      const f32x4 gg = *(const f32x4*)(g + c), sh = *(const f32x4*)(modp + c), sc = *(const f32x4*)(modp + 1024 + c);
      u32x2 o;
      o.x = pack2(v.x * rstd * (gg.x * (1.f + sc.x)) + sh.x, v.y * rstd * (gg.y * (1.f + sc.y)) + sh.y);
      o.y = pack2(v.z * rstd * (gg.z * (1.f + sc.z)) + sh.z, v.w * rstd * (gg.w * (1.f + sc.w)) + sh.w);
      *(u32x2*)(H + (size_t)row * 1024 + c) = o;
    }
  }
}

struct TileMap {
  int x, j, nloc, RB, NT, RG, per_x;
  DI void init(int MT, int NT_, int RG_) { x = blockIdx.x & 7; j = blockIdx.x >> 3; nloc = gridDim.x >> 3; RB = MT >> 3; NT = NT_; RG = RG_; per_x = RB * NT; }
  DI void get(int q, int& tm, int& tn) const { const int g = RG * NT; const int rg = q / g, rem = q % g; tn = rem / RG; tm = x * RB + rg * RG + rem % RG; }
};
DI void phase_ffn_up(PP P, int l, int f, char* smem) {
  asm volatile("" : "+s"(P));
  char* ws = P->ws;
  const int stage = l * 3 + (f ? 2 : 0);
  const int jb = f ? 6 : 0;
  const u16* Bt = (const u16*)(ws + OFF_WGU) + (size_t)(l * 2 + f) * 5632 * 1024;
  EpiAct ep; ep.act = (u16*)(ws + OFF_ACT);
  TileMap tmap; tmap.init(96, 44, 4);
  for (int q = tmap.j; q < tmap.per_x; q += tmap.nloc) {
    int tn, tm; tmap.get(q, tm, tn);
    const int m0 = tm * 128, cond = cond_of_row(m0);
    ALBf16 al; al.A = (const u16*)(ws + OFF_OMIX); al.lda = 1024;
    gemm_tile<3>(al, Bt, 1024, 1024, m0, tn * 128, ep, smem);
  }
}

DI void phase_resid_gemm(PP P, int l, size_t offA, int K, size_t offB, int jgate, float coef, int stage_next, char* smem, int part) {
  asm volatile("" : "+s"(P));
  char* ws = P->ws;
  TileMap tmap; tmap.init(96, 8, 4);
  for (int q = tmap.j; q < tmap.per_x; q += tmap.nloc) {
    int tn, tm; tmap.get(q, tm, tn);
    const int m0 = tm * 128, cond = cond_of_row(m0);
    ALBf16 al; al.A = (const u16*)(ws + offA); al.lda = K;
    EpiResid ep; ep.x = (float*)(ws + OFF_XRES); ep.gate = (const float*)(ws + OFF_MOD) + ((size_t)(l * 5 + cond) * 9 + jgate) * 1024;
    ep.coef = coef; ep.rowsq_next = (float*)(ws + OFF_ROWSQ) + (size_t)stage_next * 16 * M_;
    gemm_tile<3>(al, (const u16*)(ws + offB), K, K, m0, tn * 128, ep, smem);
  }
  if (l < 3) {
    const int rem = tmap.per_x % tmap.nloc;
    if (rem == 0 || tmap.j >= rem) {
      const int nidle = tmap.nloc - rem;
      const int worker = (int)(blockIdx.x & 7) * nidle + (tmap.j - rem), nworkers = 8 * nidle;
#pragma unroll 1
      for (int rg = 0; rg < 2; ++rg) {
        const int b0 = P->cu[l + 1][rg][0], e0 = P->cu[l + 1][rg][1];
        const int nb3 = e0 - b0;
        const int pb = b0 + (int)((long long)nb3 * (part == 0 ? 0 : part == 1 ? 4 : 6) / 10);
        const int pe = b0 + (int)((long long)nb3 * (part == 0 ? 4 : part == 1 ? 6 : 10) / 10);
        __syncthreads();
        convert_range(P, smem, pb, pe, worker, nworkers);
      }
    }
  }
}
DI void phase_inproj(PP P, int l, char* smem) {
  asm volatile("" : "+s"(P));
  char* ws = P->ws;
  const int li = l >> 1; const bool odd = l & 1;
  const int NT = odd ? 25 : 18;
  const u16* Bt = odd ? (const u16*)(ws + OFF_WINO) + (size_t)li * 3200 * 1024 : (const u16*)(ws + OFF_WINE) + (size_t)li * 2304 * 1024;
  TileMap tmap; tmap.init(96, NT, 4);
  for (int q = tmap.j; q < tmap.per_x; q += tmap.nloc) {
    int tn, tm; tmap.get(q, tm, tn);
    const int m0 = tm * 128, cond = cond_of_row(m0);
    ALBf16 al; al.A = (const u16*)(ws + OFF_OMIX); al.lda = 1024;
    if (odd) { EpiOdd ep; ep.P = P; gemm_tile<3>(al, Bt, 1024, 1024, m0, tn * 128, ep, smem); }
    else { EpiEven ep; ep.P = P; ep.li = li; gemm_tile<3>(al, Bt, 1024, 1024, m0, tn * 128, ep, smem); }
  }
}

DI void phase_upproj(PP P, int l, char* smem) {
  asm volatile("" : "+s"(P));
  char* ws = P->ws; const int li = l >> 1;
  {
    TileMap tmap; tmap.init(112, 8, 2);
    for (int q = tmap.j; q < tmap.per_x; q += tmap.nloc) {
      int tn, tm; tmap.get(q, tm, tn);
      EpiUpKV ep; ep.P = P;
      const u16* Bt = (const u16*)(ws + OFF_WUKV) + (size_t)li * 1024 * 256;
      if (tm < 96) {
        const int m0 = tm * 128;
        ALBf16Norm al; al.A = (const u16*)(ws + OFF_CKV); al.lda = 256; al.K = 256; al.g = P->in[19] + (size_t)li * 256;
        al.outn = nullptr; al.out_ld = 0;
        if (tn == 0 && m0 < MP_) {
          const int b = m0 >> 8, tt = m0 & 255;
          al.outn = P->out + OUT_CKV + ((size_t)(b * 2 + li) * 256 + tt) * 256; al.out_ld = 256;
        }
        gemm_tile<2>(al, Bt, 256, 256, m0, tn * 128, ep, smem);
      } else {
        const int cr = (tm - 96) * 128; const int b = cr >> 9, key = cr & 511;
        ALF32 al; al.A = P->in[2] + ((size_t)(b * 2 + li) * 512 + key) * 256 - (size_t)(M_ + cr) * 256; al.lda = 256;
        gemm_tile<1>(al, Bt, 256, 256, M_ + cr, tn * 128, ep, smem);
      }
    }
  }
  {
    TileMap tmap; tmap.init(96, 6, 4);
    for (int q = tmap.j; q < tmap.per_x; q += tmap.nloc) {
      int tn, tm; tmap.get(q, tm, tn);
      ALBf16Norm al; al.A = (const u16*)(ws + OFF_CQ); al.lda = 384; al.K = 384; al.g = P->in[17] + (size_t)li * 384; al.outn = nullptr; al.out_ld = 0;
      EpiUpQ ep; ep.P = P;
      gemm_tile<2>(al, (const u16*)(ws + OFF_WUQ) + (size_t)li * 768 * 384, 384, 384, tm * 128, tn * 128, ep, smem);
    }
  }
}

#define XB_TMO      128
#define XB_XCNT(j)  (256  + 64 * (j))
#define XB_XSUB(j)  (1280 + 64 * (j))
#define XB_XGEN(j)  (2304 + 64 * (j))
#define XB_TOP      3328
#define XB_TOPGEN   3392
#define XCD_BAR_WORDS 3456
#define XB_SPIN_CAP (1u << 18)
#define LAS __attribute__((address_space(3)))
DI unsigned xb_ld(unsigned* p) { return __hip_atomic_load(p, __ATOMIC_RELAXED, __HIP_MEMORY_SCOPE_AGENT); }
DI unsigned xb_add(unsigned* p, unsigned v) { return __hip_atomic_fetch_add(p, v, __ATOMIC_RELAXED, __HIP_MEMORY_SCOPE_AGENT); }
DI unsigned xb_xcc_id() { return (unsigned)__builtin_amdgcn_s_getreg((3 << 11) | 20) & 0xFu; }
#define XB_SPIN(cond, bar) do { unsigned _sp = 0; while (cond) { __builtin_amdgcn_s_sleep(1); \
    if ((++_sp & 255u) == 0u) { if (xb_ld(&(bar)[XB_TMO])) break; if (_sp > XB_SPIN_CAP) { atomicAdd(&(bar)[XB_TMO], 1u); break; } } } } while (0)
struct XcdBarrier { unsigned* bar; unsigned x; volatile LAS unsigned* st; };
DI XcdBarrier xcd_barrier_post(unsigned* bar, volatile LAS unsigned* st) {
  XcdBarrier b; b.bar = bar; b.x = xb_xcc_id(); b.st = st;
  if (tidx() == 0) (void)xb_add(&bar[XB_XCNT(b.x)], 1u);
  return b;
}
DI void xcd_barrier_complete(unsigned* bar, unsigned x, unsigned& nloc, unsigned& nx) {
  const unsigned G = gridDim.x * gridDim.y * gridDim.z;
  unsigned sum, cnt, mine, sp = 0u;
  for (;;) {
    sum = 0u; cnt = 0u; mine = 0u;
#pragma unroll
    for (unsigned j = 0; j < 16; ++j) { const unsigned c = xb_ld(&bar[XB_XCNT(j)]); sum += c; cnt += (c > 0u) ? 1u : 0u; mine = (j == x) ? c : mine; }
    if (sum == G) break;
    __builtin_amdgcn_s_sleep(1);
    if ((++sp & 255u) == 0u) { if (xb_ld(&bar[XB_TMO])) break; if (sp > XB_SPIN_CAP) { atomicAdd(&bar[XB_TMO], 1u); break; } }
  }
  nloc = mine > 0u ? mine : 1u; nx = cnt > 0u ? cnt : 1u;
}
DI void xcd_barrier(const XcdBarrier& b) {
  asm volatile("s_waitcnt vmcnt(0)" ::: "memory");
  __syncthreads();
  if (tidx() == 0) {
    unsigned* bar = b.bar;
    __builtin_amdgcn_s_waitcnt(0);
    unsigned nloc = b.st[0], nx = b.st[1];
    if (nloc == 0u) { xcd_barrier_complete(bar, b.x, nloc, nx); b.st[0] = nloc; b.st[1] = nx; }
    const unsigned old = xb_add(&bar[XB_XSUB(b.x)], 1u);
    const unsigned gen = old / nloc;
    if (old + 1u == (gen + 1u) * nloc) {
      __builtin_amdgcn_fence(__ATOMIC_RELEASE, "agent");
      asm volatile("s_waitcnt vmcnt(0)" ::: "memory");
      const unsigned og = xb_add(&bar[XB_TOP], 1u);
      const unsigned tg = og / nx;
      if (og + 1u == (tg + 1u) * nx) xb_add(&bar[XB_TOPGEN], 1u);
      else XB_SPIN(xb_ld(&bar[XB_TOPGEN]) == tg, bar);
      __builtin_amdgcn_fence(__ATOMIC_ACQUIRE, "agent");
      xb_add(&bar[XB_XGEN(b.x)], 1u);
      asm volatile("s_waitcnt vmcnt(0)" ::: "memory");
    } else {
      XB_SPIN(xb_ld(&bar[XB_XGEN(b.x)]) == gen, bar);
      __builtin_amdgcn_fence(__ATOMIC_ACQUIRE, "agent");
      asm volatile("s_waitcnt vmcnt(0)" ::: "memory");
    }
  }
  __syncthreads();
}

#ifndef PHSEL
#define PHSEL 511
#endif
#ifndef REPEAT_MASK
#define REPEAT_MASK 0
#endif
__global__ void __launch_bounds__(NTHR, 2) mega(Params Parg, int ph_lo, int ph_hi) {
  extern __shared__ __attribute__((aligned(16))) char smem[];
  cg::grid_group grid = cg::this_grid();
  PP Pk = (PP)__builtin_amdgcn_kernarg_segment_ptr();
  __shared__ __attribute__((aligned(16))) unsigned xb_words[4];
  if (tidx() < 4) xb_words[tidx()] = 0u;
  __syncthreads();
  const XcdBarrier xb = xcd_barrier_post((unsigned*)(Pk->ws + OFF_BAR), (volatile LAS unsigned*)xb_words);
  auto gsync_cg = [&]() {
    asm volatile("s_waitcnt vmcnt(0) lgkmcnt(0)" ::: "memory");
    __syncthreads();
    if (tidx() < 64) {
      __builtin_amdgcn_fence(__ATOMIC_RELEASE, "agent");
      asm volatile("s_waitcnt vmcnt(0)" ::: "memory");
    }
    grid.sync();
    __builtin_amdgcn_fence(__ATOMIC_ACQUIRE, "agent");
    asm volatile("s_waitcnt vmcnt(0)" ::: "memory");
  };
  for (int ph = ph_lo; ph < ph_hi; ++ph) {
    int kind;
    const int l = (ph - 1) / 12, s = (ph - 1) % 12;
    const bool odd = l & 1; const int li = l >> 1;
    if (ph == 0) kind = 0; else if (ph == 49) kind = 9;
    else kind = (s == 0 || s == 3 || s == 9) ? 10 : (s == 1 || s == 10) ? 1 : (s == 2 || s == 11) ? 2 : s == 4 ? 3 : s == 5 ? (odd ? 11 : 12)
              : s == 6 ? (odd ? 7 : 4) : s == 7 ? (odd ? 8 : 5) : 6;
    if (kind == 12) continue;
    if (ph > ph_lo) {
      if (ph_hi < 0) gsync_cg(); else xcd_barrier(xb);
#if (REPEAT_MASK) & 1024
      xcd_barrier(xb);
#endif
    }
    PP P = Pk;
    const int nrep = (((REPEAT_MASK) >> kind) & 1) ? 2 : 1;
    for (int rep = 0; rep < nrep; ++rep) {
      if (rep) xcd_barrier(xb);
      switch (kind) {
        case 0: phase_init(P, smem); break;
        case 9: phase_final(P); break;
        case 10: phase_hprep(P, l, s == 0 ? 0 : s == 3 ? 1 : 2); break;
        case 11: phase_gateprep(P, l); break;
        case 1: phase_ffn_up(P, l, s == 10 ? 1 : 0, smem); break;
        case 2: phase_resid_gemm(P, l, OFF_ACT, 2816, OFF_WD + (size_t)(l * 2 + (s == 11 ? 1 : 0)) * 1024 * 2816 * 2, s == 11 ? 8 : 2, 0.5f, s == 11 ? l * 3 + 3 : l * 3 + 1, smem, s == 11 ? 2 : 0); break;
        case 3: phase_inproj(P, l, smem); break;
        case 4: phase_upproj(P, l, smem); break;
        case 5: phase_attn(P, l, smem, l + 8 * rep); break;
        case 6: phase_resid_gemm(P, l, OFF_OMIX, 1024, (odd ? OFF_WOUTO : OFF_WOUTE) + (size_t)li * 1024 * 1024 * 2, 5, 1.0f, l * 3 + 2, smem, 1); break;
        case 7: phase_scan(P, l, smem, l + 8 * rep); break;
        case 8: phase_combine(P, l); break;
      }
    }
  }
}

static void add_job(Params& p, const float* src, u16* dst, int ld_src, int col0, int src_stride, int cpu, int row0, int dst_stride, int units, int K,
                    int ld_dst, int nrep = 1, int src_rep = 0, int dst_rep = 0) {
  Job& j = p.jobs[p.njobs++];
  j.src = src; j.dst = dst; j.ld_src = ld_src; j.col0 = col0; j.src_stride = src_stride; j.cpu = cpu; j.row0 = row0; j.dst_stride = dst_stride;
  j.units = units; j.K = K; j.ld_dst = ld_dst; j.nrep = nrep; j.src_rep = src_rep; j.dst_rep = dst_rep;
}

#ifndef MULTI_LAUNCH
#define MULTI_LAUNCH 0
#endif

extern "C" void kernel_launch(void* const* d_in, const int* in_sizes, int n_in, void* d_out, int out_size, void* d_ws, size_t ws_size, hipStream_t stream) {
  static Params p;
  memset(&p, 0, sizeof(p));
  for (int i = 0; i < 32; ++i) p.in[i] = (const float*)d_in[i];
  p.out = (float*)d_out; p.ws = (char*)d_ws;
  if (ws_size < WS_TOTAL) { fprintf(stderr, "workspace too small: %zu < %zu\n", ws_size, (size_t)WS_TOTAL); return; }
  char* ws = (char*)d_ws;
  for (int l = 0; l < 4; ++l)
    for (int f = 0; f < 2; ++f) {
      const size_t wi = (size_t)(l * 2 + f);
      u16* gu = (u16*)(ws + OFF_WGU) + wi * 5632 * 1024;
      add_job(p, (const float*)d_in[13] + wi * 1024 * 2816, gu, 2816, 0, 32, 32, 0, 64, 88, 1024, 1024);
      add_job(p, (const float*)d_in[14] + wi * 1024 * 2816, gu, 2816, 0, 32, 32, 32, 64, 88, 1024, 1024);
      add_job(p, (const float*)d_in[15] + wi * 2816 * 1024, (u16*)(ws + OFF_WD) + wi * 1024 * 2816, 1024, 0, 64, 64, 0, 64, 16, 2816, 2816);
    }
  for (int i = 0; i < 2; ++i) {
    const float* win = (const float*)d_in[16] + (size_t)i * 1024 * 2208;
    u16* wd = (u16*)(ws + OFF_WINE) + (size_t)i * 2304 * 1024;
    add_job(p, win, wd, 2208, 0, 64, 64, 0, 64, 10, 1024, 1024);
    add_job(p, win, wd, 2208, 672, 64, 64, 640, 64, 24, 1024, 1024);
    add_job(p, win, wd, 2208, 640, 32, 32, 2176, 32, 1, 1024, 1024);
    const float* wuq = (const float*)d_in[18] + (size_t)i * 384 * 768;
    u16* wq = (u16*)(ws + OFF_WUQ) + (size_t)i * 768 * 384;
    add_job(p, wuq, wq, 768, 0, 96, 64, 0, 64, 8, 384, 384);
    add_job(p, wuq, wq, 768, 64, 96, 32, 512, 32, 8, 384, 384);
    add_job(p, (const float*)d_in[20] + (size_t)i * 256 * 1024, (u16*)(ws + OFF_WUKV) + (size_t)i * 1024 * 256, 1024, 0, 64, 64, 0, 64, 16, 256, 256);
    add_job(p, (const float*)d_in[23] + (size_t)i * 1024 * 1024, (u16*)(ws + OFF_WOUTE) + (size_t)i * 1024 * 1024, 1024, 0, 64, 64, 0, 64, 16, 1024, 1024);
    const float* wo = (const float*)d_in[24] + (size_t)i * 1024 * 3104;
    u16* wod = (u16*)(ws + OFF_WINO) + (size_t)i * 3200 * 1024;
    add_job(p, wo, wod, 3104, 0, 64, 64, 0, 64, 16, 1024, 1024);
    add_job(p, wo, wod, 3104, 1056, 64, 64, 1024, 64, 32, 1024, 1024);
    add_job(p, wo, wod, 3104, 1024, 32, 32, 3072, 32, 1, 1024, 1024);
    add_job(p, (const float*)d_in[30] + (size_t)i * 1024 * 1024, (u16*)(ws + OFF_WOUTO) + (size_t)i * 1024 * 1024, 1024, 0, 64, 64, 0, 64, 16, 1024, 1024);
  }
  add_job(p, (const float*)d_in[5], (u16*)(ws + OFF_VDT_L), 512, 0, 64, 64, 0, 64, 8, 512, 2560, 8, 512 * 512, 4 * 128 * 2560);

  {
    int F[MAXJOBS + 1]; F[0] = 0;
    for (int j = 0; j < p.njobs; ++j) F[j + 1] = F[j] + p.jobs[j].units * (p.jobs[j].K >> 6) * p.jobs[j].nrep;
    for (int l = 0; l < 4; ++l) {
      p.cu[l][0][0] = F[6 * l]; p.cu[l][0][1] = F[6 * l + 6];
      const int i = l >> 1, base = 24 + 11 * i;
      if (l & 1) { p.cu[l][1][0] = F[base + 7]; p.cu[l][1][1] = F[base + 11]; }
      else { p.cu[l][1][0] = F[base]; p.cu[l][1][1] = F[base + 7]; }
    }
    p.cu_cache[0] = F[46]; p.cu_cache[1] = F[47];
  }
  static int grid_blocks = 0;
  if (!grid_blocks) {
    int dev = 0, cus = 0, per_cu = 0;
    hipGetDevice(&dev);
    hipDeviceGetAttribute(&cus, hipDeviceAttributeMultiprocessorCount, dev);
    hipFuncSetAttribute((const void*)mega, hipFuncAttributeMaxDynamicSharedMemorySize, SMEM_BYTES);
    hipOccupancyMaxActiveBlocksPerMultiprocessor(&per_cu, mega, NTHR, SMEM_BYTES);
    if (per_cu > 2) per_cu = 2;
    if (per_cu < 1) per_cu = 1;
    grid_blocks = cus * per_cu;
  }
  hipMemsetAsync(ws + OFF_CNT, 0, 256 + 16384, stream);
#if MULTI_LAUNCH
  for (int ph = 0; ph < 50; ++ph) hipLaunchKernelGGL(mega, dim3(grid_blocks), dim3(NTHR), SMEM_BYTES, stream, p, ph, ph + 1);
#else
  int lo = 0, hi = 50;
  void* args[] = {&p, &lo, &hi};
  hipError_t e = hipLaunchCooperativeKernel((void*)mega, dim3(grid_blocks), dim3(NTHR), args, SMEM_BYTES, stream);
  if (e != hipSuccess) fprintf(stderr, "cooperative launch failed: %s (grid %d)\n", hipGetErrorString(e), grid_blocks);
#endif
}
```

```cpp
#include <hip/hip_runtime.h>
#include <hip/hip_cooperative_groups.h>
#include <cstdio>
#include <cstring>
namespace cg = cooperative_groups;

#define DI __device__ __forceinline__
typedef unsigned short u16;
typedef short bf16x8 __attribute__((ext_vector_type(8)));
typedef float f32x16 __attribute__((ext_vector_type(16)));
typedef __bf16 bf2_t __attribute__((ext_vector_type(2)));
typedef float f2_t __attribute__((ext_vector_type(2)));
typedef unsigned u32x4 __attribute__((ext_vector_type(4)));
typedef float f32x4 __attribute__((ext_vector_type(4)));
typedef unsigned u32x2 __attribute__((ext_vector_type(2)));
typedef float f32x2 __attribute__((ext_vector_type(2)));
#define MFMA(a, b, c) __builtin_amdgcn_mfma_f32_32x32x16_bf16((a), (b), (c), 0, 0, 0)

constexpr int M_ = 12288, MP_ = 4096;
constexpr int NTHR = 256;

constexpr size_t AL(size_t x) { return (x + 255) & ~(size_t)255; }
constexpr size_t OFF_XRES = 0;
constexpr size_t OFF_ACT = OFF_XRES + AL((size_t)M_ * 1024 * 4);
constexpr size_t OFF_ROWSQ = OFF_ACT + AL((size_t)M_ * 2816 * 2);
constexpr size_t OFF_MOD = OFF_ROWSQ + AL((size_t)13 * 16 * M_ * 4);
constexpr size_t OFF_CNT = OFF_MOD + AL((size_t)4 * 5 * 9216 * 4);
constexpr size_t OFF_BAR = OFF_CNT + 256;
constexpr size_t OFF_WGU = OFF_BAR + 16384;
constexpr size_t OFF_WD = OFF_WGU + AL((size_t)8 * 5632 * 1024 * 2);
constexpr size_t OFF_WINE = OFF_WD + AL((size_t)8 * 1024 * 2816 * 2);
constexpr size_t OFF_WUQ = OFF_WINE + AL((size_t)2 * 2304 * 1024 * 2);
constexpr size_t OFF_WUKV = OFF_WUQ + AL((size_t)2 * 768 * 384 * 2);
constexpr size_t OFF_WOUTE = OFF_WUKV + AL((size_t)2 * 1024 * 256 * 2);
constexpr size_t OFF_WINO = OFF_WOUTE + AL((size_t)2 * 1024 * 1024 * 2);
constexpr size_t OFF_WOUTO = OFF_WINO + AL((size_t)2 * 3200 * 1024 * 2);
constexpr size_t OFF_KD_L = OFF_WOUTO + AL((size_t)2 * 1024 * 1024 * 2);
constexpr size_t OFF_VDT_L = OFF_KD_L + AL((size_t)4 * 2 * 4 * 2560 * 128 * 2);
constexpr size_t OFF_KR_L = OFF_VDT_L + AL((size_t)4 * 2 * 4 * 2560 * 128 * 2);
constexpr size_t OFF_OMIX = OFF_KR_L + AL((size_t)4 * 2 * 2560 * 32 * 2);
constexpr size_t OFF_UNION = OFF_OMIX + AL((size_t)M_ * 1024 * 2);
constexpr size_t OFF_CQ = OFF_UNION;
constexpr size_t OFF_CKV = OFF_CQ + AL((size_t)M_ * 384 * 2);
constexpr size_t OFF_QA = OFF_CKV + AL((size_t)M_ * 256 * 2);
constexpr size_t OFF_QD = OFF_QA + AL((size_t)8 * M_ * 96 * 2);
constexpr size_t OFF_KN_P = OFF_QD + AL((size_t)4 * M_ * 128 * 2);
constexpr size_t OFF_KN_L = OFF_KN_P + AL((size_t)8 * 4096 * 64 * 2);
constexpr size_t OFF_VAT_P = OFF_KN_L + AL((size_t)4 * 8 * 2560 * 64 * 2);
constexpr size_t OFF_VAT_L = OFF_VAT_P + AL((size_t)16 * 8 * 64 * 256 * 2);
constexpr size_t OFF_KR_P = OFF_VAT_L + AL((size_t)4 * 8 * 64 * 2560 * 2);
constexpr size_t OFF_KD_P = OFF_KR_P + AL((size_t)4096 * 32 * 2);
constexpr size_t OFF_VDT_P = OFF_KD_P + AL((size_t)4 * 4096 * 128 * 2);
constexpr size_t OFF_EVEN_END = OFF_VDT_P + AL((size_t)16 * 4 * 128 * 256 * 2);
constexpr size_t OFF_GQ = OFF_UNION;
constexpr size_t OFF_GK = OFF_GQ + AL((size_t)M_ * 256 * 2);
constexpr size_t OFF_RQ = OFF_GK + AL((size_t)M_ * 256 * 2);
constexpr size_t OFF_RK = OFF_RQ + AL((size_t)M_ * 256 * 2);
constexpr size_t OFF_GV = OFF_RK + AL((size_t)M_ * 256 * 2);
constexpr size_t OFF_RV = OFF_GV + AL((size_t)M_ * 512 * 2);
constexpr size_t OFF_GATE = OFF_RV + AL((size_t)M_ * 512 * 2);
constexpr size_t OFF_GLR = OFF_GATE + AL((size_t)M_ * 1024 * 2);
constexpr size_t OFF_GG = OFF_GLR + AL((size_t)M_ * 32 * 4);
constexpr size_t OFF_ODD_END = OFF_GG + AL((size_t)M_ * 512 * 4);
constexpr size_t WS_TOTAL = OFF_EVEN_END > OFF_ODD_END ? OFF_EVEN_END : OFF_ODD_END;

constexpr size_t OUT_Y = 0;
constexpr size_t OUT_CKV = 12582912;
constexpr size_t OUT_KROPE = OUT_CKV + 2097152;
constexpr size_t OUT_DK = OUT_KROPE + 262144;
constexpr size_t OUT_DV = OUT_DK + 4194304;
constexpr size_t OUT_SG = OUT_DV + 4194304;
constexpr size_t OUT_SR = OUT_SG + 2097152;

struct Job {
  const float* src; u16* dst;
  int ld_src, col0, src_stride, cpu, row0, dst_stride, units, K, ld_dst, nrep, src_rep, dst_rep;
};
constexpr int MAXJOBS = 48;
struct Params {
  const float* in[32];
  float* out;
  char* ws;
  int njobs; int pad0;
  int cu[4][2][2];
  int cu_cache[2];
  Job jobs[MAXJOBS];
};

typedef const __attribute__((address_space(4))) Params* PP;

DI int tidx() { int t; asm volatile("v_mov_b32 %0, %1" : "=v"(t) : "v"(threadIdx.x)); return t; }
DI unsigned pack2(float a, float b) { f2_t v = {a, b}; bf2_t r = __builtin_convertvector(v, bf2_t); return __builtin_bit_cast(unsigned, r); }
DI u16 f2bf(float a) { return (u16)(pack2(a, 0.f) & 0xffffu); }
DI float bf2f(u16 v) { return __uint_as_float(((unsigned)v) << 16); }
DI float bflo(unsigned v) { return __uint_as_float(v << 16); }
DI float bfhi(unsigned v) { return __uint_as_float(v & 0xffff0000u); }
DI float tguard(float y) { asm volatile("s_nop 0" : "+v"(y)); return y; }
DI float silu_f(float x) { return x * tguard(__builtin_amdgcn_rcpf(1.f + tguard(__expf(-x)))); }
DI float logsigmoid_f(float x) { return fminf(x, 0.f) - log1pf(__expf(-fabsf(x))); }
DI int crow(int reg, int h) { return (reg & 3) + 8 * (reg >> 2) + 4 * h; }
DI void sincos_rev(float ang, float& s, float& c) {
  float rev = ang * 0.15915494309189535f; rev = rev - floorf(rev);
  s = __builtin_amdgcn_sinf(rev); c = __builtin_amdgcn_cosf(rev);
  asm volatile("s_nop 1" : "+v"(s), "+v"(c));
}
DI float fexp2(float x) { float y = __builtin_amdgcn_exp2f(x); asm volatile("s_nop 0" : "+v"(y)); return y; }
DI float fexp(float x) { float y = __builtin_amdgcn_exp2f(x * 1.4426950408889634f); asm volatile("s_nop 0" : "+v"(y)); return y; }
DI float wave_sum(float v) {
  v += __shfl_xor(v, 32); v += __shfl_xor(v, 16); v += __shfl_xor(v, 8); v += __shfl_xor(v, 4); v += __shfl_xor(v, 2); v += __shfl_xor(v, 1); return v;
}
DI float half_sum(float v) {
  v += __shfl_xor(v, 16); v += __shfl_xor(v, 8); v += __shfl_xor(v, 4); v += __shfl_xor(v, 2); v += __shfl_xor(v, 1); return v;
}
DI int cond_of_row(int row) { return row < MP_ ? 0 : 1 + ((row - MP_) >> 11); }

constexpr int LDT = 72;

struct ALBf16 {
  const u16* A; int lda; int m0; int tid;
  struct Regs { u32x4 v[4]; };
  DI void init(int m0_, char*, int tid_) { m0 = m0_; tid = tid_; }
  DI void load(int k0, Regs& R) {
    const u16* p = A + (size_t)(m0 + (tid >> 3)) * lda + k0 + (tid & 7) * 8;
#pragma unroll
    for (int i = 0; i < 4; ++i) R.v[i] = *(const u32x4*)(p + (size_t)i * 32 * lda);
  }
  DI void store(const Regs& R, u16* sA) {
#pragma unroll
    for (int i = 0; i < 4; ++i) *(u32x4*)(sA + ((tid >> 3) + 32 * i) * LDT + (tid & 7) * 8) = R.v[i];
  }
};

struct ALF32 {
  const float* A; int lda; int m0; int tid;
  struct Regs { f32x4 v[8]; };
  DI void init(int m0_, char*, int tid_) { m0 = m0_; tid = tid_; }
  DI void load(int k0, Regs& R) {
    const float* p = A + (size_t)(m0 + (tid >> 4)) * lda + k0 + (tid & 15) * 4;
#pragma unroll
    for (int i = 0; i < 8; ++i) R.v[i] = *(const f32x4*)(p + (size_t)i * 16 * lda);
  }
  DI void store(const Regs& R, u16* sA) {
#pragma unroll
    for (int i = 0; i < 8; ++i) {
      u32x2 o; o.x = pack2(R.v[i].x, R.v[i].y); o.y = pack2(R.v[i].z, R.v[i].w);
      *(u32x2*)(sA + ((tid >> 4) + 16 * i) * LDT + (tid & 15) * 4) = o;
    }
  }
};

struct ALBf16Norm {
  const u16* A; int lda; int K; const float* g; float* outn; size_t out_ld; int m0; int tid;
  float rstd[4];
  struct Regs { u32x4 v[4]; f32x4 g0, g1; };
  DI void init(int m0_, char* smem, int tid_) {
    m0 = m0_; tid = tid_;
    float* sR = (float*)smem;
    const int row = tid >> 1, hf = tid & 1;
    const int n8 = K / 16;
    const u16* p = A + (size_t)(m0 + row) * lda + hf * (K / 2);
    float ss = 0.f;
    for (int i = 0; i < n8; ++i) {
      u32x4 q = *(const u32x4*)(p + i * 8);
      float a;
      a = bflo(q.x); ss += a * a; a = bfhi(q.x); ss += a * a; a = bflo(q.y); ss += a * a; a = bfhi(q.y); ss += a * a;
      a = bflo(q.z); ss += a * a; a = bfhi(q.z); ss += a * a; a = bflo(q.w); ss += a * a; a = bfhi(q.w); ss += a * a;
    }
    ss += __shfl_xor(ss, 1);
    const float rs = tguard(rsqrtf(ss / (float)K + 1e-6f));
    __syncthreads();
    if (hf == 0) sR[row] = rs;
    if (outn) {
      float* op = outn + (size_t)row * out_ld + hf * (K / 2);
      const float* gp = g + hf * (K / 2);
      for (int i = 0; i < n8; ++i) {
        u32x4 q = *(const u32x4*)(p + i * 8);
        f32x4 ga = *(const f32x4*)(gp + i * 8), gb = *(const f32x4*)(gp + i * 8 + 4);
        f32x4 o0, o1;
        o0.x = bflo(q.x) * rs * ga.x; o0.y = bfhi(q.x) * rs * ga.y; o0.z = bflo(q.y) * rs * ga.z; o0.w = bfhi(q.y) * rs * ga.w;
        o1.x = bflo(q.z) * rs * gb.x; o1.y = bfhi(q.z) * rs * gb.y; o1.z = bflo(q.w) * rs * gb.z; o1.w = bfhi(q.w) * rs * gb.w;
        *(f32x4*)(op + i * 8) = o0; *(f32x4*)(op + i * 8 + 4) = o1;
      }
    }
    __syncthreads();
#pragma unroll
    for (int i = 0; i < 4; ++i) rstd[i] = sR[(tid >> 3) + 32 * i];
  }
  DI void load(int k0, Regs& R) {
    const int c = k0 + (tid & 7) * 8;
    const u16* p = A + (size_t)(m0 + (tid >> 3)) * lda + c;
#pragma unroll
    for (int i = 0; i < 4; ++i) R.v[i] = *(const u32x4*)(p + (size_t)i * 32 * lda);
    R.g0 = *(const f32x4*)(g + c); R.g1 = *(const f32x4*)(g + c + 4);
  }
  DI void store(const Regs& R, u16* sA) {
#pragma unroll
    for (int i = 0; i < 4; ++i) {
      const float r = rstd[i]; u32x4 q = R.v[i], o;
      o.x = pack2(bflo(q.x) * r * R.g0.x, bfhi(q.x) * r * R.g0.y);
      o.y = pack2(bflo(q.y) * r * R.g0.z, bfhi(q.y) * r * R.g0.w);
      o.z = pack2(bflo(q.z) * r * R.g1.x, bfhi(q.z) * r * R.g1.y);
      o.w = pack2(bflo(q.w) * r * R.g1.z, bfhi(q.w) * r * R.g1.w);
      *(u32x4*)(sA + ((tid >> 3) + 32 * i) * LDT + (tid & 7) * 8) = o;
    }
  }
};

constexpr int SMEM_BYTES = 4 * 128 * LDT * 2 + 64;
template <int NST, class ALT, class EPT>
DI void gemm_tile(ALT& al, const u16* __restrict__ Bt, int ldb, int K, int m0, int n0, EPT& ep, char* smem) {
  u16* sbuf = (u16*)smem;
  const int tid = tidx(), lane = tid & 63, w = tid >> 6, r = lane & 31, h = lane >> 5;
  const int wm = w >> 1, wn = w & 1;
  f32x16 acc[2][2];
#pragma unroll
  for (int i = 0; i < 2; ++i)
#pragma unroll
    for (int j = 0; j < 2; ++j)
#pragma unroll
      for (int e = 0; e < 16; ++e) acc[i][j][e] = 0.f;
  __syncthreads();
  al.init(m0, smem, tid);
  __syncthreads();
  typename ALT::Regs ra[3];
  u32x4 rb[2][4];
  const int brow = tid >> 3, bcol = (tid & 7) * 8;
  const u16* bp = Bt + (size_t)(n0 + brow) * ldb + bcol;
  const int KT = K >> 6;
  auto gloadA = [&](int kt, int slot) { al.load(kt * 64, ra[slot]); };
  auto gloadB = [&](int kt, int slot) {
#pragma unroll
    for (int i = 0; i < 4; ++i) rb[slot][i] = *(const u32x4*)(bp + (size_t)i * 32 * ldb + kt * 64);
  };
  auto lstore = [&](int slotA, int slotB, int buf) {
    u16* sA = sbuf + buf * (256 * LDT); u16* sB = sA + 128 * LDT;
    al.store(ra[slotA], sA);
#pragma unroll
    for (int i = 0; i < 4; ++i) *(u32x4*)(sB + (brow + 32 * i) * LDT + bcol) = rb[slotB][i];
  };
  auto compute = [&](int buf) {
    const u16* sA = sbuf + buf * (256 * LDT); const u16* sB = sA + 128 * LDT;
    const u16* pa = sA + (wm * 64 + r) * LDT + h * 8;
    const u16* pb = sB + (wn * 64 + r) * LDT + h * 8;
    bf16x8 fa[2][2], fb[2][2];
    fa[0][0] = *(const bf16x8*)(pa); fa[0][1] = *(const bf16x8*)(pa + 32 * LDT);
    fb[0][0] = *(const bf16x8*)(pb); fb[0][1] = *(const bf16x8*)(pb + 32 * LDT);
#pragma unroll
    for (int ks = 0; ks < 4; ++ks) {
      const int cur = ks & 1, nxt = cur ^ 1;
      if (ks < 3) {
        fa[nxt][0] = *(const bf16x8*)(pa + (ks + 1) * 16); fa[nxt][1] = *(const bf16x8*)(pa + 32 * LDT + (ks + 1) * 16);
        fb[nxt][0] = *(const bf16x8*)(pb + (ks + 1) * 16); fb[nxt][1] = *(const bf16x8*)(pb + 32 * LDT + (ks + 1) * 16);
      }
      __builtin_amdgcn_sched_barrier(0);
      acc[0][0] = MFMA(fa[cur][0], fb[cur][0], acc[0][0]);
      acc[0][1] = MFMA(fa[cur][0], fb[cur][1], acc[0][1]);
      acc[1][0] = MFMA(fa[cur][1], fb[cur][0], acc[1][0]);
      acc[1][1] = MFMA(fa[cur][1], fb[cur][1], acc[1][1]);
      __builtin_amdgcn_sched_barrier(0);
    }
  };
  gloadA(0, 0); gloadB(0, 0);
  if (KT > 1) { gloadA(1, 1); gloadB(1, 1); }
  if (KT > 2) gloadA(2, 2);
  lstore(0, 0, 0);
  if (KT > 2) gloadB(2, 0);
  if (KT > 3) gloadA(3, 0);
  __syncthreads();
  for (int kt0 = 0; kt0 < KT; kt0 += 6) {
#pragma unroll
    for (int u = 0; u < 6; ++u) {
      const int kt = kt0 + u;
      if (kt < KT) {
        if (kt + 1 < KT) {
          lstore((u + 1) % 3, (u + 1) & 1, (u + 1) & 1);
          if (kt + 3 < KT) gloadB(kt + 3, (u + 1) & 1);
          if (kt + 4 < KT) gloadA(kt + 4, (u + 1) % 3);
        }
        __builtin_amdgcn_sched_barrier(0);
        __builtin_amdgcn_s_setprio(2);
        compute(u & 1);
        __builtin_amdgcn_s_setprio(0);
        __syncthreads();
      }
    }
  }
  ep(acc, m0, n0);
}

struct EpiAct {
  u16* act;
  DI void operator()(f32x16 (&acc)[2][2], int m0, int n0) {
    const int tid_ = tidx(); const int lane = tid_ & 63, w = tid_ >> 6, r = lane & 31, h = lane >> 5, wm = w >> 1, wn = w & 1;
    const int col = (n0 >> 1) + wn * 32 + r;
#pragma unroll
    for (int i = 0; i < 2; ++i)
#pragma unroll
      for (int e = 0; e < 16; ++e) {
        const int row = m0 + wm * 64 + i * 32 + crow(e, h);
        act[(size_t)row * 2816 + col] = f2bf(silu_f(acc[i][0][e]) * acc[i][1][e]);
      }
  }
};

struct EpiResid {
  float* x; const float* gate; float coef; float* rowsq_next;
  DI void operator()(f32x16 (&acc)[2][2], int m0, int n0) {
    const int tid_ = tidx(); const int lane = tid_ & 63, w = tid_ >> 6, r = lane & 31, h = lane >> 5, wm = w >> 1, wn = w & 1;
    const int c0 = n0 + wn * 64 + r;
    const float g0 = gate[c0] * coef, g1 = gate[c0 + 32] * coef;
    float* xb = x + (size_t)(m0 + wm * 64) * 1024 + c0;
#pragma unroll
    for (int i = 0; i < 2; ++i) {
      float xa[16], xc[16];
#pragma unroll
      for (int e = 0; e < 16; ++e) {
        const float* xp = xb + (size_t)(i * 32 + crow(e, h)) * 1024;
        xa[e] = xp[0]; xc[e] = xp[32];
      }
      __builtin_amdgcn_sched_barrier(0);
      float ssq[16];
#pragma unroll
      for (int e = 0; e < 16; ++e) {
        float* xp = xb + (size_t)(i * 32 + crow(e, h)) * 1024;
        const float a = xa[e] + g0 * acc[i][0][e];
        const float b = xc[e] + g1 * acc[i][1][e];
        xp[0] = a; xp[32] = b;
        ssq[e] = a * a + b * b;
      }
#pragma unroll
      for (int e = 0; e < 16; ++e) {
        const float sred = half_sum(ssq[e]);
        if (r == 0) rowsq_next[(size_t)((n0 >> 7) * 2 + wn) * M_ + m0 + wm * 64 + i * 32 + crow(e, h)] = sred;
      }
    }
  }
};

struct EpiEven {
  PP P; int li;
  DI void operator()(f32x16 (&acc)[2][2], int m0, int n0) {
    char* ws = P->ws; float* out = P->out;
    const int tid_ = tidx(); const int lane = tid_ & 63, w = tid_ >> 6, r = lane & 31, h = lane >> 5, wm = w >> 1, wn = w & 1;
    const int tn = n0 >> 7;
    const bool lat = m0 >= MP_;
    if (tn < 5) {
      u16* dst = tn < 3 ? (u16*)(ws + OFF_CQ) : (u16*)(ws + OFF_CKV);
      const int ld = tn < 3 ? 384 : 256;
      const int cb = (tn < 3 ? tn : tn - 3) * 128 + wn * 64 + r;
#pragma unroll
      for (int i = 0; i < 2; ++i)
#pragma unroll
        for (int j = 0; j < 2; ++j)
#pragma unroll
          for (int e = 0; e < 16; ++e) {
            const int row = m0 + wm * 64 + i * 32 + crow(e, h);
            dst[(size_t)row * ld + cb + j * 32] = f2bf(acc[i][j][e]);
          }
    } else if (tn < 13) {
      const bool isq = tn < 9;
      const int hh = isq ? tn - 5 : tn - 9;
      const float inv = exp2f(-(float)(r & 15) * (13.287712379549449f / 16.f));
      const bool first = (r & 16) == 0;
#pragma unroll
      for (int i = 0; i < 2; ++i)
#pragma unroll
        for (int j = 0; j < 2; ++j)
#pragma unroll
          for (int e = 0; e < 16; ++e) {
            const int row = m0 + wm * 64 + i * 32 + crow(e, h);
            float v = acc[i][j][e];
            const int c = wn * 64 + j * 32 + r;
            if (lat) {
              const int t = (row - MP_) & 2047;
              const float pos = (j == 0) ? (float)(t >> 6) : (float)(t & 63);
              float sn, cs; sincos_rev(pos * inv, sn, cs);
              const float pv = __shfl_xor(v, 16);
              v = first ? (v * cs - pv * sn) : (v * cs + pv * sn);
              const int b = (row - MP_) >> 11;
              if (isq) ((u16*)(ws + OFF_QD))[((size_t)hh * M_ + row) * 128 + c] = f2bf(v);
              else ((u16*)(ws + OFF_KD_L))[((size_t)((b * 2 + li) * 4 + hh) * 2560 + 512 + t) * 128 + c] = f2bf(v);
            } else {
              if (isq) ((u16*)(ws + OFF_QD))[((size_t)hh * M_ + row) * 128 + c] = f2bf(v);
              else {
                ((u16*)(ws + OFF_KD_P))[((size_t)hh * 4096 + row) * 128 + c] = f2bf(v);
                const int b = row >> 8, t = row & 255;
                out[OUT_DK + ((size_t)((b * 2 + li) * 256 + t) * 4 + hh) * 128 + c] = v;
              }
            }
          }
    } else if (tn < 17) {
      const int hh = tn - 13;
#pragma unroll
      for (int i = 0; i < 2; ++i)
#pragma unroll
        for (int j = 0; j < 2; ++j) {
          const int d = wn * 64 + j * 32 + r;
#pragma unroll
          for (int g = 0; g < 4; ++g) {
            const int row0 = m0 + wm * 64 + i * 32 + 8 * g + 4 * h;
            u32x2 pk; pk.x = pack2(acc[i][j][4 * g], acc[i][j][4 * g + 1]); pk.y = pack2(acc[i][j][4 * g + 2], acc[i][j][4 * g + 3]);
            if (lat) {
              const int b = (row0 - MP_) >> 11, t = (row0 - MP_) & 2047;
              *(u32x2*)((u16*)(ws + OFF_VDT_L) + ((size_t)((b * 2 + li) * 4 + hh) * 128 + d) * 2560 + 512 + t) = pk;
            } else {
              const int b = row0 >> 8, t = row0 & 255;
              *(u32x2*)((u16*)(ws + OFF_VDT_P) + ((size_t)(b * 4 + hh) * 128 + d) * 256 + t) = pk;
#pragma unroll
              for (int q = 0; q < 4; ++q)
                out[OUT_DV + ((size_t)((b * 2 + li) * 256 + t + q) * 4 + hh) * 128 + d] = acc[i][j][4 * g + q];
            }
          }
        }
    } else {
      if (wn == 0) {
        const float inv = exp2f(-(float)(r & 7) * (13.287712379549449f / 8.f));
        const bool first = (r & 8) == 0;
#pragma unroll
        for (int i = 0; i < 2; ++i)
#pragma unroll
          for (int e = 0; e < 16; ++e) {
            const int row = m0 + wm * 64 + i * 32 + crow(e, h);
            float v = acc[i][0][e];
            if (lat) {
              const int t = (row - MP_) & 2047, b = (row - MP_) >> 11;
              const float pos = (r < 16) ? (float)(t >> 6) : (float)(t & 63);
              float sn, cs; sincos_rev(pos * inv, sn, cs);
              const float pv = __shfl_xor(v, 8);
              v = first ? (v * cs - pv * sn) : (v * cs + pv * sn);
              ((u16*)(ws + OFF_KR_L))[((size_t)(b * 2 + li) * 2560 + 512 + t) * 32 + r] = f2bf(v);
            } else {
              ((u16*)(ws + OFF_KR_P))[(size_t)row * 32 + r] = f2bf(v);
              const int b = row >> 8, t = row & 255;
              out[OUT_KROPE + ((size_t)(b * 2 + li) * 256 + t) * 32 + r] = v;
            }
          }
      }
    }
  }
};

struct EpiUpQ {
  PP P;
  DI void operator()(f32x16 (&acc)[2][2], int m0, int n0) {
    u16* qa = (u16*)(P->ws + OFF_QA);
    const int tid_ = tidx(); const int lane = tid_ & 63, w = tid_ >> 6, r = lane & 31, h = lane >> 5, wm = w >> 1, wn = w & 1;
    const int tn = n0 >> 7;
    const bool lat = m0 >= MP_;
    if (tn < 4) {
      const int head = tn * 2 + wn;
#pragma unroll
      for (int i = 0; i < 2; ++i)
#pragma unroll
        for (int j = 0; j < 2; ++j)
#pragma unroll
          for (int e = 0; e < 16; ++e) {
            const int row = m0 + wm * 64 + i * 32 + crow(e, h);
            qa[((size_t)head * M_ + row) * 96 + j * 32 + r] = f2bf(acc[i][j][e]);
          }
    } else {
      const float inv = exp2f(-(float)(r & 7) * (13.287712379549449f / 8.f));
      const bool first = (r & 8) == 0;
#pragma unroll
      for (int i = 0; i < 2; ++i)
#pragma unroll
        for (int j = 0; j < 2; ++j) {
          const int head = (tn - 4) * 4 + wn * 2 + j;
#pragma unroll
          for (int e = 0; e < 16; ++e) {
            const int row = m0 + wm * 64 + i * 32 + crow(e, h);
            float v = acc[i][j][e];
            if (lat) {
              const int t = (row - MP_) & 2047;
              const float pos = (r < 16) ? (float)(t >> 6) : (float)(t & 63);
              float sn, cs; sincos_rev(pos * inv, sn, cs);
              const float pv = __shfl_xor(v, 8);
              v = first ? (v * cs - pv * sn) : (v * cs + pv * sn);
            }
            qa[((size_t)head * M_ + row) * 96 + 64 + r] = f2bf(v);
          }
        }
    }
  }
};

struct EpiUpKV {
  PP P;
  DI void operator()(f32x16 (&acc)[2][2], int m0, int n0) {
    char* ws = P->ws;
    const int tid_ = tidx(); const int lane = tid_ & 63, w = tid_ >> 6, r = lane & 31, h = lane >> 5, wm = w >> 1, wn = w & 1;
    const int head = n0 >> 7;
#pragma unroll
    for (int i = 0; i < 2; ++i)
#pragma unroll
      for (int j = 0; j < 2; ++j) {
        const int d = j * 32 + r;
#pragma unroll
        for (int g = 0; g < 4; ++g) {
          const int row0 = m0 + wm * 64 + i * 32 + 8 * g + 4 * h;
          bool isp; int b, key;
          if (row0 < MP_) { isp = true; b = row0 >> 8; key = row0 & 255; }
          else if (row0 < M_) { isp = false; b = (row0 - MP_) >> 11; key = 512 + ((row0 - MP_) & 2047); }
          else { isp = false; b = (row0 - M_) >> 9; key = (row0 - M_) & 511; }
          if (wn == 0) {
            u16* kp = isp ? (u16*)(ws + OFF_KN_P) + ((size_t)head * 4096 + b * 256 + key) * 64 + d
                          : (u16*)(ws + OFF_KN_L) + ((size_t)(b * 8 + head) * 2560 + key) * 64 + d;
#pragma unroll
            for (int q = 0; q < 4; ++q) kp[q * 64] = f2bf(acc[i][j][4 * g + q]);
          } else {
            u32x2 pk; pk.x = pack2(acc[i][j][4 * g], acc[i][j][4 * g + 1]); pk.y = pack2(acc[i][j][4 * g + 2], acc[i][j][4 * g + 3]);
            u16* vp = isp ? (u16*)(ws + OFF_VAT_P) + ((size_t)(b * 8 + head) * 64 + d) * 256 + key
                          : (u16*)(ws + OFF_VAT_L) + ((size_t)(b * 8 + head) * 64 + d) * 2560 + key;
            *(u32x2*)vp = pk;
          }
        }
      }
  }
};

struct EpiOdd {
  PP P;
  DI void operator()(f32x16 (&acc)[2][2], int m0, int n0) {
    char* ws = P->ws;
    const int tid_ = tidx(); const int lane = tid_ & 63, w = tid_ >> 6, r = lane & 31, h = lane >> 5, wm = w >> 1, wn = w & 1;
    const int tn = n0 >> 7;
    const bool lat = m0 >= MP_;
    if (tn == 24) {
      if (wn == 0) {
        float* glr = (float*)(ws + OFF_GLR);
#pragma unroll
        for (int i = 0; i < 2; ++i)
#pragma unroll
          for (int e = 0; e < 16; ++e) {
            const int row = m0 + wm * 64 + i * 32 + crow(e, h);
            glr[(size_t)row * 32 + r] = acc[i][0][e];
          }
      }
      return;
    }
    u16* dst; int ld, cb; float scl = 1.f; bool rope = false;
    if (tn < 2) { dst = (u16*)(ws + OFF_GQ); ld = 256; cb = tn * 128; scl = 0.125f; }
    else if (tn < 4) { dst = (u16*)(ws + OFF_GK); ld = 256; cb = (tn - 2) * 128; }
    else if (tn < 8) { dst = (u16*)(ws + OFF_GV); ld = 512; cb = (tn - 4) * 128; }
    else if (tn < 12) { dst = (u16*)(ws + OFF_GATE); ld = 1024; cb = (tn - 8) * 128; }
    else if (tn < 14) { dst = (u16*)(ws + OFF_RQ); ld = 256; cb = (tn - 12) * 128; rope = lat; }
    else if (tn < 16) { dst = (u16*)(ws + OFF_RK); ld = 256; cb = (tn - 14) * 128; scl = 0.125f; rope = lat; }
    else if (tn < 20) { dst = (u16*)(ws + OFF_RV); ld = 512; cb = (tn - 16) * 128; }
    else { dst = (u16*)(ws + OFF_GATE); ld = 1024; cb = 512 + (tn - 20) * 128; }
    const float inv = exp2f(-(float)r * (13.287712379549449f / 32.f));
#pragma unroll
    for (int i = 0; i < 2; ++i)
#pragma unroll
      for (int e = 0; e < 16; ++e) {
        const int row = m0 + wm * 64 + i * 32 + crow(e, h);
        float v0 = acc[i][0][e] * scl, v1 = acc[i][1][e] * scl;
        if (rope) {
          const int t = (row - MP_) & 2047;
          float sn, cs; sincos_rev((float)t * inv, sn, cs);
          const float a = v0 * cs - v1 * sn, b = v1 * cs + v0 * sn;
          v0 = a; v1 = b;
        }
        u16* p = dst + (size_t)row * ld + cb + wn * 64 + r;
        p[0] = f2bf(v0); p[32] = f2bf(v1);
      }
  }
};

DI void convert_range(PP P, char* smem, int ub, int ue, int first, int stride) {
  float* sT = (float*)smem;
  const int tid = tidx();
  const int c = tid & 63, kr = tid >> 6;
  const int kp = tid & 31, nr = tid >> 5;
  const float* csrc = nullptr; u16* cdst = nullptr; int cld_src = 0, cld_dst = 0, ccpu = 0;
  auto decode = [&](int u) {
    int j = 0, rem = u;
    for (;; ++j) { const int n = P->jobs[j].units * (P->jobs[j].K >> 6) * P->jobs[j].nrep; if (rem < n) break; rem -= n; }
    const auto& J = P->jobs[j];
    const int kts = J.K >> 6;
    const int kt = rem % kts; int t2 = rem / kts; const int un = t2 % J.units; const int rep = t2 / J.units;
    csrc = J.src + (size_t)rep * J.src_rep + (size_t)(kt * 64) * J.ld_src + J.col0 + un * J.src_stride;
    cdst = J.dst + (size_t)rep * J.dst_rep + (size_t)(J.row0 + un * J.dst_stride) * J.ld_dst + kt * 64;
    cld_src = J.ld_src; cld_dst = J.ld_dst; ccpu = J.cpu;
  };
  float v[16];
  const int u0 = ub + first;
  if (u0 < ue) {
    decode(u0);
#pragma unroll
    for (int kk = 0; kk < 16; ++kk) v[kk] = c < ccpu ? csrc[(size_t)(kk * 4 + kr) * cld_src + c] : 0.f;
  }
  for (int u = u0; u < ue; u += stride) {
    u16* dst = cdst; const int ld_dst = cld_dst, cpu = ccpu;
    __syncthreads();
#pragma unroll
    for (int kk = 0; kk < 16; ++kk) sT[(kk * 4 + kr) * 65 + c] = v[kk];
    __syncthreads();
    if (u + stride < ue) {
      decode(u + stride);
#pragma unroll
      for (int kk = 0; kk < 16; ++kk) v[kk] = c < ccpu ? csrc[(size_t)(kk * 4 + kr) * cld_src + c] : 0.f;
    }
#pragma unroll 4
    for (int nn = 0; nn < 8; ++nn) {
      const int n = nn * 8 + nr;
      if (n < cpu) *(unsigned*)(dst + (size_t)n * ld_dst + kp * 2) = pack2(sT[(2 * kp) * 65 + n], sT[(2 * kp + 1) * 65 + n]);
    }
  }
}

DI void phase_init(PP P, char* smem) {
  asm volatile("" : "+s"(P));
  char* ws = P->ws;
  const int tid = tidx(), lane = tid & 63, w = tid >> 6;
  const int nb = gridDim.x, bid = blockIdx.x;
  {
    float* rs = (float*)(ws + OFF_ROWSQ) + M_;
    for (int i = bid * NTHR + tid; i < 15 * M_; i += nb * NTHR) rs[i] = 0.f;
    if (bid == 0 && tid < 64) ((int*)(ws + OFF_CNT))[tid] = 0;
  }
  {
    float* xr = (float*)(ws + OFF_XRES); float* rs0 = (float*)(ws + OFF_ROWSQ);
    for (int row = bid * 4 + w; row < M_; row += nb * 4) {
      const float* src = row < MP_ ? P->in[0] + (size_t)row * 1024 : P->in[1] + (size_t)(row - MP_) * 1024;
      float ss = 0.f;
#pragma unroll
      for (int i = 0; i < 4; ++i) {
        f32x4 v = *(const f32x4*)(src + (i * 64 + lane) * 4);
        *(f32x4*)(xr + (size_t)row * 1024 + (i * 64 + lane) * 4) = v;
        ss += v.x * v.x + v.y * v.y + v.z * v.z + v.w * v.w;
      }
      ss = wave_sum(ss);
      if (lane == 0) rs0[row] = ss;
    }
  }
  {
    u16* kd = (u16*)(ws + OFF_KD_L);
    const int n4 = 4 * 2 * 512 * 4 * 128 / 4;
    for (int i4 = bid * NTHR + tid; i4 < n4; i4 += nb * NTHR) {
      const int e = i4 * 4;
      const int c = e & 127, hh = (e >> 7) & 3, key = (e >> 9) & 511, bi = e >> 18;
      f32x4 v = *(const f32x4*)(P->in[4] + e);
      u32x2 o; o.x = pack2(v.x, v.y); o.y = pack2(v.z, v.w);
      *(u32x2*)(kd + ((size_t)(bi * 4 + hh) * 2560 + key) * 128 + c) = o;
    }
    u16* kr = (u16*)(ws + OFF_KR_L);
    const int m4 = 4 * 2 * 512 * 32 / 4;
    for (int i4 = bid * NTHR + tid; i4 < m4; i4 += nb * NTHR) {
      const int e = i4 * 4;
      const int c = e & 31, key = (e >> 5) & 511, bi = e >> 14;
      f32x4 v = *(const f32x4*)(P->in[3] + e);
      u32x2 o; o.x = pack2(v.x, v.y); o.y = pack2(v.z, v.w);
      *(u32x2*)(kr + ((size_t)bi * 2560 + key) * 32 + c) = o;
    }
  }
  {
    float* sC = (float*)smem;
    float* sRed = sC + 5 * 1024;
    for (int i = tid; i < 5 * 1024; i += NTHR) {
      const float v = i < 1024 ? P->in[9][i] : P->in[8][i - 1024];
      sC[i] = silu_f(v);
    }
    __syncthreads();
    float* mod = (float*)(ws + OFF_MOD);
    float* sRed2 = sC + 5 * 1024;
    const int cg = tid & 15, kg = tid >> 4;
    for (int u = bid; u < 4 * 144; u += nb) {
      const int l = u / 144, n0 = (u % 144) * 64;
      const float* wp = P->in[10] + ((size_t)l * 1024 + kg * 64) * 9216 + n0 + cg * 4;
      f32x4 a0 = {0.f, 0.f, 0.f, 0.f}, a1 = a0, a2 = a0, a3 = a0, a4 = a0;
#pragma unroll 16
      for (int k = 0; k < 64; ++k) {
        const f32x4 wv = *(const f32x4*)(wp + (size_t)k * 9216);
        const int kk = kg * 64 + k;
        a0 += sC[kk] * wv; a1 += sC[1024 + kk] * wv; a2 += sC[2048 + kk] * wv; a3 += sC[3072 + kk] * wv; a4 += sC[4096 + kk] * wv;
      }
      *(f32x4*)(sRed2 + (kg * 5 + 0) * 64 + cg * 4) = a0; *(f32x4*)(sRed2 + (kg * 5 + 1) * 64 + cg * 4) = a1;
      *(f32x4*)(sRed2 + (kg * 5 + 2) * 64 + cg * 4) = a2; *(f32x4*)(sRed2 + (kg * 5 + 3) * 64 + cg * 4) = a3;
      *(f32x4*)(sRed2 + (kg * 5 + 4) * 64 + cg * 4) = a4;
      __syncthreads();
      for (int o = tid; o < 5 * 64; o += NTHR) {
        const int j = o >> 6, cc = o & 63;
        float sum = 0.f;
#pragma unroll
        for (int g = 0; g < 16; ++g) sum += sRed2[(g * 5 + j) * 64 + cc];
        mod[((size_t)l * 5 + j) * 9216 + n0 + cc] = sum + P->in[11][(size_t)l * 9216 + n0 + cc];
      }
      __syncthreads();
    }
  }
  __syncthreads();
  convert_range(P, smem, P->cu[0][0][0], P->cu[0][0][1], bid, nb);
  convert_range(P, smem, P->cu[0][1][0], P->cu[0][1][1], bid, nb);
  convert_range(P, smem, P->cu_cache[0], P->cu_cache[1], bid, nb);
}

template <int DQK, int DV, bool MLA>
DI void attn_pass(const u16* __restrict__ Q, int qstride, const u16* __restrict__ K, int kstride, const u16* __restrict__ KR,
                  const u16* __restrict__ VT, int Lk, float c_scale, f32x16 (&O)[DV / 32], char* smem) {
  constexpr int LDK = DQK + 8, CPR = DQK / 8, NKC = 64 * CPR / NTHR, NVC = DV * 8 / NTHR, NT = DV / 32;
  u16* sK = (u16*)smem;
  u16* sV = sK + 64 * 104;
  const int tid = tidx(), lane = tid & 63, w = tid >> 6, r = lane & 31, h = lane >> 5;
  bf16x8 qf[DQK / 16];
  {
    const u16* qp = Q + (size_t)(w * 32 + r) * qstride + h * 8;
#pragma unroll
    for (int ks = 0; ks < DQK / 16; ++ks) qf[ks] = *(const bf16x8*)(qp + ks * 16);
  }
#pragma unroll
  for (int t = 0; t < NT; ++t)
#pragma unroll
    for (int e = 0; e < 16; ++e) O[t][e] = 0.f;
  float m_run = -1e30f, l_part = 0.f;
  u32x4 kreg[NKC], vreg[NVC];
  auto gload = [&](int key0) {
#pragma unroll
    for (int p = 0; p < NKC; ++p) {
      const int id = tid + NTHR * p; const int key = id / CPR, c = id % CPR;
      if (MLA && c >= 8) kreg[p] = *(const u32x4*)(KR + (size_t)(key0 + key) * 32 + (c - 8) * 8);
      else kreg[p] = *(const u32x4*)(K + (size_t)(key0 + key) * kstride + c * 8);
    }
#pragma unroll
    for (int p = 0; p < NVC; ++p) {
      const int id = tid + NTHR * p; const int d = id >> 3, c = id & 7;
      vreg[p] = *(const u32x4*)(VT + (size_t)d * Lk + key0 + c * 8);
    }
  };
  gload(0);
  const int ntiles = Lk >> 6;
  for (int kt = 0; kt < ntiles; ++kt) {
    __syncthreads();
#pragma unroll
    for (int p = 0; p < NKC; ++p) { const int id = tid + NTHR * p; const int key = id / CPR, c = id % CPR; *(u32x4*)(sK + key * LDK + c * 8) = kreg[p]; }
#pragma unroll
    for (int p = 0; p < NVC; ++p) { const int id = tid + NTHR * p; const int d = id >> 3, c = id & 7; *(u32x4*)(sV + d * 72 + c * 8) = vreg[p]; }
    __syncthreads();
    if (kt + 1 < ntiles) gload((kt + 1) * 64);
    __builtin_amdgcn_sched_barrier(0);
    f32x16 S[2];
#pragma unroll
    for (int sub = 0; sub < 2; ++sub)
#pragma unroll
      for (int e = 0; e < 16; ++e) S[sub][e] = 0.f;
    {
      constexpr int NS = 2 * (DQK / 16);
      bf16x8 kf[2];
      kf[0] = *(const bf16x8*)(sK + r * LDK + h * 8);
#pragma unroll
      for (int st = 0; st < NS; ++st) {
        const int ks = st >> 1, sub = st & 1;
        if (st + 1 < NS) { const int ks1 = (st + 1) >> 1, sub1 = (st + 1) & 1; kf[(st + 1) & 1] = *(const bf16x8*)(sK + (sub1 * 32 + r) * LDK + ks1 * 16 + h * 8); }
        __builtin_amdgcn_sched_barrier(0);
        S[sub] = MFMA(kf[st & 1], qf[ks], S[sub]);
        __builtin_amdgcn_sched_barrier(0);
      }
    }
    union VF { u32x2 u[2]; bf16x8 v; };
    VF vf[2][NT];
#pragma unroll
    for (int t = 0; t < NT; ++t) {
      const u16* vp = sV + (t * 32 + r) * 72 + 4 * h;
      vf[0][t].u[0] = *(const u32x2*)vp; vf[0][t].u[1] = *(const u32x2*)(vp + 8);
    }
    float mx = S[0][0];
#pragma unroll
    for (int e = 0; e < 16; ++e) { mx = fmaxf(mx, S[0][e]); mx = fmaxf(mx, S[1][e]); }
    mx = fmaxf(mx, __shfl_xor(mx, 32));
    const float m_new = fmaxf(m_run, mx * c_scale);
    const float alpha = fexp2(m_run - m_new);
    m_run = m_new;
    float ls = 0.f;
#pragma unroll
    for (int sub = 0; sub < 2; ++sub)
#pragma unroll
      for (int e = 0; e < 16; ++e) { const float p = fexp2(S[sub][e] * c_scale - m_new); S[sub][e] = p; ls += p; }
    l_part = l_part * alpha + ls;
#pragma unroll
    for (int t = 0; t < NT; ++t)
#pragma unroll
      for (int e = 0; e < 16; ++e) O[t][e] *= alpha;
#pragma unroll
    for (int g = 0; g < 4; ++g) {
      const int sub = g >> 1, s2 = g & 1;
      if (g < 3) {
        const int sub1 = (g + 1) >> 1, s21 = (g + 1) & 1;
#pragma unroll
        for (int t = 0; t < NT; ++t) {
          const u16* vp = sV + (t * 32 + r) * 72 + sub1 * 32 + 16 * s21 + 4 * h;
          vf[(g + 1) & 1][t].u[0] = *(const u32x2*)vp; vf[(g + 1) & 1][t].u[1] = *(const u32x2*)(vp + 8);
        }
      }
      union { unsigned u[4]; bf16x8 v; } pf;
#pragma unroll
      for (int q = 0; q < 4; ++q) pf.u[q] = pack2(S[sub][8 * s2 + 2 * q], S[sub][8 * s2 + 2 * q + 1]);
      __builtin_amdgcn_sched_barrier(0);
#pragma unroll
      for (int t = 0; t < NT; ++t) O[t] = MFMA(vf[g & 1][t].v, pf.v, O[t]);
      __builtin_amdgcn_sched_barrier(0);
    }
  }
  const float l = l_part + __shfl_xor(l_part, 32);
  const float il = 1.f / l;
#pragma unroll
  for (int t = 0; t < NT; ++t)
#pragma unroll
    for (int e = 0; e < 16; ++e) O[t][e] *= il;
}

DI void phase_attn(PP P, int l, char* smem, int cidx) {
  asm volatile("" : "+s"(P));
  char* ws = P->ws;
  const int li = l >> 1;
  const int tid = tidx(), lane = tid & 63, w = tid >> 6, r = lane & 31, h = lane >> 5;
  int* cnt = (int*)(ws + OFF_CNT) + cidx;
  int* sItem = (int*)(smem + 48 * 1024);
  const float lam_init = 0.8f - 0.6f * __expf(-0.3f * (float)l);
  float lam;
  {
    const float* lp = P->in[21] + (size_t)li * 4 * 64;
    const float a = wave_sum(lp[lane] * lp[64 + lane]);
    const float b = wave_sum(lp[128 + lane] * lp[192 + lane]);
    lam = __expf(a) - __expf(b) + lam_init;
  }
  u16* omix = (u16*)(ws + OFF_OMIX);
  float* stash = (float*)(ws + OFF_ACT) + (size_t)blockIdx.x * (64 * NTHR);
  const float LOG2E = 1.4426950408889634f;
  for (;;) {
    __syncthreads();
    if (tid == 0) *sItem = atomicAdd(cnt, 1);
    __syncthreads();
    const int item = *sItem;
    if (item >= 1152) break;
    bool lat, diff; int b, hd, qb;
    if (item < 256) { lat = true; diff = true; b = item >> 6; hd = (item >> 4) & 3; qb = item & 15; }
    else if (item < 768) { const int it = item - 256; lat = true; diff = false; b = it >> 7; hd = (it >> 4) & 7; qb = it & 15; }
    else if (item < 896) { const int it = item - 768; lat = false; diff = true; b = it >> 3; hd = (it >> 1) & 3; qb = it & 1; }
    else { const int it = item - 896; lat = false; diff = false; b = it >> 4; hd = (it >> 1) & 7; qb = it & 1; }
    const int row0 = lat ? MP_ + b * 2048 + qb * 128 : b * 256 + qb * 128;
    const int Lk = lat ? 2560 : 256;
    if (!diff) {
#ifndef NO_MLA
      const u16* Q = (const u16*)(ws + OFF_QA) + ((size_t)hd * M_ + row0) * 96;
      const u16* K = lat ? (const u16*)(ws + OFF_KN_L) + (size_t)(b * 8 + hd) * 2560 * 64 : (const u16*)(ws + OFF_KN_P) + ((size_t)hd * 4096 + b * 256) * 64;
      const u16* KR = lat ? (const u16*)(ws + OFF_KR_L) + (size_t)(b * 2 + li) * 2560 * 32 : (const u16*)(ws + OFF_KR_P) + (size_t)(b * 256) * 32;
      const u16* VT = lat ? (const u16*)(ws + OFF_VAT_L) + (size_t)(b * 8 + hd) * 64 * 2560 : (const u16*)(ws + OFF_VAT_P) + (size_t)(b * 8 + hd) * 64 * 256;
      f32x16 O[2];
      attn_pass<96, 64, true>(Q, 96, K, 64, KR, VT, Lk, 0.10206207261596575f * LOG2E, O, smem);
      u16* op = omix + (size_t)(row0 + w * 32 + r) * 1024 + hd * 64;
#pragma unroll
      for (int t = 0; t < 2; ++t)
#pragma unroll
        for (int g = 0; g < 4; ++g) {
          u32x2 pk; pk.x = pack2(O[t][4 * g], O[t][4 * g + 1]); pk.y = pack2(O[t][4 * g + 2], O[t][4 * g + 3]);
          *(u32x2*)(op + t * 32 + 8 * g + 4 * h) = pk;
        }
#endif
    } else {
#ifndef NO_DIFF
      const u16* Q = (const u16*)(ws + OFF_QD) + ((size_t)hd * M_ + row0) * 128;
      const u16* K = lat ? (const u16*)(ws + OFF_KD_L) + (size_t)((b * 2 + li) * 4 + hd) * 2560 * 128 : (const u16*)(ws + OFF_KD_P) + ((size_t)hd * 4096 + b * 256) * 128;
      const u16* VT = lat ? (const u16*)(ws + OFF_VDT_L) + (size_t)((b * 2 + li) * 4 + hd) * 128 * 2560 : (const u16*)(ws + OFF_VDT_P) + (size_t)(b * 4 + hd) * 128 * 256;
      f32x16 O[4];
      float ss = 0.f;
      float* st = stash + tid * 64;
#pragma unroll 1
      for (int pass = 0; pass < 2; ++pass) {
        attn_pass<64, 128, false>(Q + pass * 64, 128, K + pass * 64, 128, nullptr, VT, Lk, 0.125f * LOG2E, O, smem);
        if (pass == 0) {
#pragma unroll
          for (int t = 0; t < 4; ++t)
#pragma unroll
            for (int g = 0; g < 4; ++g) {
              f32x4 v; v.x = O[t][4 * g]; v.y = O[t][4 * g + 1]; v.z = O[t][4 * g + 2]; v.w = O[t][4 * g + 3];
              *(f32x4*)(st + t * 16 + 4 * g) = v;
            }
        }
      }
#pragma unroll
      for (int t = 0; t < 4; ++t) {
#pragma unroll
        for (int g = 0; g < 4; ++g) {
          const f32x4 v = *(const f32x4*)(st + t * 16 + 4 * g);
          O[t][4 * g] = v.x - lam * O[t][4 * g]; O[t][4 * g + 1] = v.y - lam * O[t][4 * g + 1];
          O[t][4 * g + 2] = v.z - lam * O[t][4 * g + 2]; O[t][4 * g + 3] = v.w - lam * O[t][4 * g + 3];
          ss += O[t][4 * g] * O[t][4 * g] + O[t][4 * g + 1] * O[t][4 * g + 1] + O[t][4 * g + 2] * O[t][4 * g + 2] + O[t][4 * g + 3] * O[t][4 * g + 3];
        }
        __builtin_amdgcn_sched_barrier(0);
      }
      ss += __shfl_xor(ss, 32);
      const float rs = tguard(rsqrtf(ss * (1.f / 128.f) + 1e-6f)) * (1.f - lam_init);
      const float* sg = P->in[22] + (size_t)li * 128;
      u16* op = omix + (size_t)(row0 + w * 32 + r) * 1024 + 512 + hd * 128;
#pragma unroll
      for (int t = 0; t < 4; ++t)
#pragma unroll
        for (int g = 0; g < 4; ++g) {
          const int d = t * 32 + 8 * g + 4 * h;
          const f32x4 gv = *(const f32x4*)(sg + d);
          u32x2 pk; pk.x = pack2(O[t][4 * g] * rs * gv.x, O[t][4 * g + 1] * rs * gv.y); pk.y = pack2(O[t][4 * g + 2] * rs * gv.z, O[t][4 * g + 3] * rs * gv.w);
          *(u32x2*)(op + d) = pk;
        }
#endif
    }
  }
}

DI void phase_gateprep(PP P, int l) {
  asm volatile("" : "+s"(P));
  char* ws = P->ws;
  const int li = l >> 1;
  const int d = tidx();
  const float* glr = (const float*)(ws + OFF_GLR);
  float* gg = (float*)(ws + OFF_GG);
  const int dir = blockIdx.x & 1;
  float wg[16];
  const float* wp = P->in[25] + ((size_t)(li * 2 + dir) * 16) * 256 + d;
#pragma unroll
  for (int q = 0; q < 16; ++q) wg[q] = wp[q * 256];
  const float bg = P->in[26][(size_t)(li * 2 + dir) * 256 + d];
  for (int row = blockIdx.x >> 1; row < M_; row += gridDim.x >> 1) {
    const f32x4* gp = (const f32x4*)(glr + (size_t)row * 32 + dir * 16);
    const f32x4 g0 = gp[0], g1 = gp[1], g2 = gp[2], g3 = gp[3];
    const float lg = bg + g0.x * wg[0] + g0.y * wg[1] + g0.z * wg[2] + g0.w * wg[3] + g1.x * wg[4] + g1.y * wg[5] + g1.z * wg[6] + g1.w * wg[7]
                     + g2.x * wg[8] + g2.y * wg[9] + g2.z * wg[10] + g2.w * wg[11] + g3.x * wg[12] + g3.y * wg[13] + g3.z * wg[14] + g3.w * wg[15];
    gg[(size_t)row * 512 + dir * 256 + d] = logsigmoid_f(lg) * (1.f / 16.f);
  }
}

DI void phase_scan(PP P, int l, char* smem, int cidx) {
  asm volatile("" : "+s"(P));
  char* ws = P->ws; float* out = P->out;
  const int li = l >> 1;
  const int tid = tidx(), lane = tid & 63, w = tid >> 6, r = lane & 31, h = lane >> 5;
  u16* sQ = (u16*)smem;
  u16* sK = sQ + 64 * LDT;
  u16* sKT = sK + 64 * LDT;
  u16* sVT = sKT + 64 * LDT;
  u16* sS = sVT + 64 * LDT;
  float* sSeg = (float*)(sS + 64 * LDT);
  float* sTot = sSeg + 256;
  int* sItem = (int*)(sTot + 64);
  int* cnt = (int*)(ws + OFF_CNT) + cidx;
  const int tt = w & 1, vt = w >> 1;
  for (;;) {
    __syncthreads();
    if (tid == 0) *sItem = atomicAdd(cnt, 1);
    __syncthreads();
    const int item = *sItem;
    if (item >= 640) break;
    bool lat; int mx, b, hd, dir, vh;
    if (item < 128) { lat = true; vh = item & 1; dir = (item >> 1) & 1; hd = (item >> 2) & 3; b = (item >> 4) & 3; mx = item >> 6; }
    else { const int it = item - 128; lat = false; vh = it & 1; dir = (it >> 1) & 1; hd = (it >> 2) & 3; b = (it >> 4) & 15; mx = it >> 8; }
    const int T = lat ? 2048 : 256, NC = T >> 6;
    const int rb = lat ? MP_ + b * 2048 : b * 256;
    const u16* Qg = (const u16*)(ws + (mx ? OFF_RQ : OFF_GQ));
    const u16* Kg = (const u16*)(ws + (mx ? OFF_RK : OFF_GK));
    const u16* Vg = (const u16*)(ws + (mx ? OFF_RV : OFF_GV));
    u16* ob = (u16*)(ws + OFF_ACT) + (size_t)dir * M_ * 1024;
    const int d = tid & 63, part = tid >> 6;
    const float* gg = (const float*)(ws + OFF_GG) + dir * 256 + hd * 64 + d;
    float lgam = 0.f;
    if (mx) lgam = log1pf(-exp2f(-P->in[28][(li * 2 + dir) * 4 + hd]));
    f32x16 St;
    if (lat) {
      const float* sp = P->in[mx ? 7 : 6] + ((size_t)((b * 2 + li) * 2 + dir) * 4 + hd) * 8192 + (size_t)(tt * 32 + r) * 128 + vh * 64 + vt * 32;
#pragma unroll
      for (int g = 0; g < 4; ++g) {
        const f32x4 v = *(const f32x4*)(sp + 8 * g + 4 * h);
        St[4 * g] = v.x; St[4 * g + 1] = v.y; St[4 * g + 2] = v.z; St[4 * g + 3] = v.w;
      }
    } else {
#pragma unroll
      for (int e = 0; e < 16; ++e) St[e] = 0.f;
    }
    u16 rq[16], rk[16], rv[16]; float rg[16];
    auto issue = [&](int c) {
#pragma unroll
      for (int j = 0; j < 16; ++j) {
        const int t = part * 16 + j;
        const int tok = dir == 0 ? c * 64 + t : T - 1 - (c * 64 + t);
        const int row = rb + tok;
        rq[j] = Qg[(size_t)row * 256 + hd * 64 + d];
        rk[j] = Kg[(size_t)row * 256 + hd * 64 + d];
        rv[j] = Vg[(size_t)row * 512 + hd * 128 + vh * 64 + d];
        rg[j] = mx == 0 ? gg[(size_t)row * 512] : lgam;
      }
    };
    issue(0);
    for (int c = 0; c < NC; ++c) {
#pragma unroll
      for (int e = 0; e < 16; ++e) sS[(vt * 32 + crow(e, h)) * LDT + tt * 32 + r] = f2bf(St[e]);
      float qv[16], kv[16], cum[16];
      float run = 0.f;
#pragma unroll
      for (int j = 0; j < 16; ++j) {
        const int t = part * 16 + j;
        qv[j] = bf2f(rq[j]);
        kv[j] = bf2f(rk[j]);
        run += rg[j]; cum[j] = run;
        sVT[d * LDT + t] = rv[j];
      }
      sSeg[part * 64 + d] = run;
      __syncthreads();
      float off = 0.f, tot = 0.f;
#pragma unroll
      for (int p = 0; p < 4; ++p) { const float s = sSeg[p * 64 + d]; tot += s; if (p < part) off += s; }
      if (part == 0) sTot[d] = fexp(tot);
#pragma unroll
      for (int j = 0; j < 16; ++j) {
        const int t = part * 16 + j;
        const float bc = cum[j] + off;
        sQ[t * LDT + d] = f2bf(qv[j] * fexp(bc));
        sK[t * LDT + d] = f2bf(kv[j] * fexp(-bc));
        sKT[d * LDT + t] = f2bf(kv[j] * fexp(tot - bc));
      }
      __syncthreads();
      if (c + 1 < NC) issue(c + 1);
      __builtin_amdgcn_sched_barrier(0);
      bf16x8 qf[4];
#pragma unroll
      for (int ks = 0; ks < 4; ++ks) qf[ks] = *(const bf16x8*)(sQ + (tt * 32 + r) * LDT + ks * 16 + h * 8);
      f32x16 Ot;
#pragma unroll
      for (int e = 0; e < 16; ++e) Ot[e] = 0.f;
#pragma unroll
      for (int ks = 0; ks < 4; ++ks) {
        const bf16x8 a = *(const bf16x8*)(sS + (vt * 32 + r) * LDT + ks * 16 + h * 8);
        Ot = MFMA(a, qf[ks], Ot);
      }
      for (int st = 0; st <= tt; ++st) {
        f32x16 At;
#pragma unroll
        for (int e = 0; e < 16; ++e) At[e] = 0.f;
#pragma unroll
        for (int ks = 0; ks < 4; ++ks) {
          const bf16x8 a = *(const bf16x8*)(sK + (st * 32 + r) * LDT + ks * 16 + h * 8);
          At = MFMA(a, qf[ks], At);
        }
        if (st == tt) {
#pragma unroll
          for (int e = 0; e < 16; ++e) if (crow(e, h) > r) At[e] = 0.f;
        }
#pragma unroll
        for (int s2 = 0; s2 < 2; ++s2) {
          union { unsigned u[4]; bf16x8 v; } pf;
#pragma unroll
          for (int q = 0; q < 4; ++q) pf.u[q] = pack2(At[8 * s2 + 2 * q], At[8 * s2 + 2 * q + 1]);
          const u16* vp = sVT + (vt * 32 + r) * LDT + st * 32 + 16 * s2 + 4 * h;
          union { u32x2 u[2]; bf16x8 v; } vf;
          vf.u[0] = *(const u32x2*)vp; vf.u[1] = *(const u32x2*)(vp + 8);
          Ot = MFMA(vf.v, pf.v, Ot);
        }
      }
      {
        const int t = tt * 32 + r;
        const int tok = dir == 0 ? c * 64 + t : T - 1 - (c * 64 + t);
        u16* op = ob + (size_t)(rb + tok) * 1024 + mx * 512 + hd * 128 + vh * 64 + vt * 32;
#pragma unroll
        for (int g = 0; g < 4; ++g) {
          u32x2 pk; pk.x = pack2(Ot[4 * g], Ot[4 * g + 1]); pk.y = pack2(Ot[4 * g + 2], Ot[4 * g + 3]);
          *(u32x2*)(op + 8 * g + 4 * h) = pk;
        }
      }
      {
        const float dec = sTot[tt * 32 + r];
#pragma unroll
        for (int e = 0; e < 16; ++e) St[e] *= dec;
#pragma unroll
        for (int ks = 0; ks < 4; ++ks) {
          const bf16x8 a = *(const bf16x8*)(sVT + (vt * 32 + r) * LDT + ks * 16 + h * 8);
          const bf16x8 bb = *(const bf16x8*)(sKT + (tt * 32 + r) * LDT + ks * 16 + h * 8);
          St = MFMA(a, bb, St);
        }
      }
      __syncthreads();
    }
    if (!lat) {
      float* op = out + (mx ? OUT_SR : OUT_SG) + ((size_t)((b * 2 + li) * 2 + dir) * 4 + hd) * 8192 + (size_t)(tt * 32 + r) * 128 + vh * 64 + vt * 32;
#pragma unroll
      for (int g = 0; g < 4; ++g) {
        f32x4 v; v.x = St[4 * g]; v.y = St[4 * g + 1]; v.z = St[4 * g + 2]; v.w = St[4 * g + 3];
        *(f32x4*)(op + 8 * g + 4 * h) = v;
      }
    }
  }
}

DI void phase_combine(PP P, int l) {
  asm volatile("" : "+s"(P));
  char* ws = P->ws;
  const int li = l >> 1;
  const int tid_ = tidx(); const int lane = tid_ & 63, w = tid_ >> 6;
  const unsigned* of = (const unsigned*)(ws + OFF_ACT);
  const unsigned* obk = of + (size_t)M_ * 512;
  const unsigned* gate = (const unsigned*)(ws + OFF_GATE);
  unsigned* omix = (unsigned*)(ws + OFF_OMIX);
  const f32x2 gn = *(const f32x2*)(P->in[27] + (size_t)li * 128 + 2 * lane);
  const f32x2 rn = *(const f32x2*)(P->in[29] + (size_t)li * 128 + 2 * lane);
  for (int row = blockIdx.x * 4 + w; row < M_; row += gridDim.x * 4) {
#pragma unroll
    for (int mh = 0; mh < 8; ++mh) {
      const size_t idx = (size_t)row * 512 + mh * 64 + lane;
      const unsigned a = of[idx], b = obk[idx], gt = gate[idx];
      float o0 = bflo(a) + bflo(b), o1 = bfhi(a) + bfhi(b);
      float y0, y1;
      if (mh < 4) {
        const float ss = wave_sum(o0 * o0 + o1 * o1);
        const float rs = tguard(rsqrtf(ss * (1.f / 128.f) + 1e-6f));
        y0 = o0 * rs * gn.x; y1 = o1 * rs * gn.y;
      } else {
        const float mu = wave_sum(o0 + o1) * (1.f / 128.f);
        const float d0 = o0 - mu, d1 = o1 - mu;
        const float var = wave_sum(d0 * d0 + d1 * d1) * (1.f / 128.f);
        const float rs = tguard(rsqrtf(var + 1e-6f));
        y0 = d0 * rs * rn.x; y1 = d1 * rs * rn.y;
      }
      y0 *= silu_f(bflo(gt)); y1 *= silu_f(bfhi(gt));
      omix[idx] = pack2(y0, y1);
    }
  }
}

DI void phase_final(PP P) {
  asm volatile("" : "+s"(P));
  char* ws = P->ws;
  const int tid_ = tidx(); const int lane = tid_ & 63, w = tid_ >> 6;
  const float* xr = (const float*)(ws + OFF_XRES);
  const float* rs = (const float*)(ws + OFF_ROWSQ) + (size_t)12 * 16 * M_;
  for (int row = blockIdx.x * 4 + w; row < M_; row += gridDim.x * 4) {
    float ssum = 0.f;
#pragma unroll
    for (int i = 0; i < 16; ++i) ssum += rs[(size_t)i * M_ + row];
    const float rstd = tguard(rsqrtf(ssum * (1.f / 1024.f) + 1e-6f));
#pragma unroll
    for (int i = 0; i < 4; ++i) {
      const int c = (i * 64 + lane) * 4;
      f32x4 v = *(const f32x4*)(xr + (size_t)row * 1024 + c);
      const f32x4 g = *(const f32x4*)(P->in[31] + c);
      v.x *= rstd * g.x; v.y *= rstd * g.y; v.z *= rstd * g.z; v.w *= rstd * g.w;
      *(f32x4*)(P->out + OUT_Y + (size_t)row * 1024 + c) = v;
    }
  }
}

DI void phase_hprep(PP P, int l, int sidx) {
  asm volatile("" : "+s"(P));
  char* ws = P->ws;
  const int tid_ = tidx(); const int lane = tid_ & 63, w = tid_ >> 6;
  const float* xr = (const float*)(ws + OFF_XRES);
  const float* rs = (const float*)(ws + OFF_ROWSQ) + (size_t)(l * 3 + sidx) * 16 * M_;
  const float* g = P->in[12] + (size_t)(l * 3 + sidx) * 1024;
  u16* H = (u16*)(ws + OFF_OMIX);
  const int rstep = gridDim.x * 4;
  for (int row0 = blockIdx.x * 4 + w; row0 < M_; row0 += 2 * rstep) {
    const int row1 = row0 + rstep;
    const bool has1 = row1 < M_;
    const int rr1 = has1 ? row1 : row0;
    float s0 = 0.f, s1 = 0.f;
#pragma unroll
    for (int i = 0; i < 16; ++i) { s0 += rs[(size_t)i * M_ + row0]; s1 += rs[(size_t)i * M_ + rr1]; }
    f32x4 v0[4], v1[4];
#pragma unroll
    for (int i = 0; i < 4; ++i) {
      const int c = (i * 64 + lane) * 4;
      v0[i] = *(const f32x4*)(xr + (size_t)row0 * 1024 + c);
      v1[i] = *(const f32x4*)(xr + (size_t)rr1 * 1024 + c);
    }
    __builtin_amdgcn_sched_barrier(0);
    const float rstd0 = tguard(rsqrtf(s0 * (1.f / 1024.f) + 1e-6f));
    const float rstd1 = tguard(rsqrtf(s1 * (1.f / 1024.f) + 1e-6f));
    const float* mp0 = (const float*)(ws + OFF_MOD) + ((size_t)(l * 5 + cond_of_row(row0)) * 9 + sidx * 3) * 1024;
    const float* mp1 = (const float*)(ws + OFF_MOD) + ((size_t)(l * 5 + cond_of_row(rr1)) * 9 + sidx * 3) * 1024;
#pragma unroll
    for (int i = 0; i < 4; ++i) {
      const int c = (i * 64 + lane) * 4;
      const f32x4 gg = *(const f32x4*)(g + c);
      {
        const f32x4 v = v0[i], sh = *(const f32x4*)(mp0 + c), sc = *(const f32x4*)(mp0 + 1024 + c);
        u32x2 o;
        o.x = pack2(v.x * rstd0 * (gg.x * (1.f + sc.x)) + sh.x, v.y * rstd0 * (gg.y * (1.f + sc.y)) + sh.y);
        o.y = pack2(v.z * rstd0 * (gg.z * (1.f + sc.z)) + sh.z, v.w * rstd0 * (gg.w * (1.f + sc.w)) + sh.w);
        *(u32x2*)(H + (size_t)row0 * 1024 + c) = o;
      }
      if (has1) {
        const f32x4 v = v1[i], sh = *(const f32x4*)(mp1 + c), sc = *(const f32x4*)(mp1 + 1024 + c);
        u32x2 o;
        o.x = pack2(v.x * rstd1 * (gg.x * (1.f + sc.x)) + sh.x, v.y * rstd1 * (gg.y * (1.f + sc.y)) + sh.y);
        o.y = pack2(v.z * rstd1 * (gg.z * (1.f + sc.z)) + sh.z, v.w * rstd1 * (gg.w * (1.f + sc.w)) + sh.w);
        *(u32x2*)(H + (size_t)row1 * 1024 + c) = o;
      }
    }
  }
}

struct TileMap {
  int x, j, nloc, RB, NT, RG, per_x;
  DI void init(int MT, int NT_, int RG_) { x = blockIdx.x & 7; j = blockIdx.x >> 3; nloc = gridDim.x >> 3; RB = MT >> 3; NT = NT_; RG = RG_; per_x = RB * NT; }
  DI void get(int q, int& tm, int& tn) const { const int g = RG * NT; const int rg = q / g, rem = q % g; tn = rem / RG; tm = x * RB + rg * RG + rem % RG; }
};
DI void phase_ffn_up(PP P, int l, int f, char* smem) {
  asm volatile("" : "+s"(P));
  char* ws = P->ws;
  const int stage = l * 3 + (f ? 2 : 0);
  const int jb = f ? 6 : 0;
  const u16* Bt = (const u16*)(ws + OFF_WGU) + (size_t)(l * 2 + f) * 5632 * 1024;
  EpiAct ep; ep.act = (u16*)(ws + OFF_ACT);
  TileMap tmap; tmap.init(96, 44, 4);
  for (int q = tmap.j; q < tmap.per_x; q += tmap.nloc) {
    int tn, tm; tmap.get(q, tm, tn);
    const int m0 = tm * 128, cond = cond_of_row(m0);
    ALBf16 al; al.A = (const u16*)(ws + OFF_OMIX); al.lda = 1024;
    gemm_tile<3>(al, Bt, 1024, 1024, m0, tn * 128, ep, smem);
  }
}

DI void phase_resid_gemm(PP P, int l, size_t offA, int K, size_t offB, int jgate, float coef, int stage_next, char* smem, int part) {
  asm volatile("" : "+s"(P));
  char* ws = P->ws;
  TileMap tmap; tmap.init(96, 8, 4);
  for (int q = tmap.j; q < tmap.per_x; q += tmap.nloc) {
    int tn, tm; tmap.get(q, tm, tn);
    const int m0 = tm * 128, cond = cond_of_row(m0);
    ALBf16 al; al.A = (const u16*)(ws + offA); al.lda = K;
    EpiResid ep; ep.x = (float*)(ws + OFF_XRES); ep.gate = (const float*)(ws + OFF_MOD) + ((size_t)(l * 5 + cond) * 9 + jgate) * 1024;
    ep.coef = coef; ep.rowsq_next = (float*)(ws + OFF_ROWSQ) + (size_t)stage_next * 16 * M_;
    gemm_tile<3>(al, (const u16*)(ws + offB), K, K, m0, tn * 128, ep, smem);
  }
  if (l < 3) {
    const int rem = tmap.per_x % tmap.nloc;
    if (rem == 0 || tmap.j >= rem) {
      const int nidle = tmap.nloc - rem;
      const int worker = (int)(blockIdx.x & 7) * nidle + (tmap.j - rem), nworkers = 8 * nidle;
#pragma unroll 1
      for (int rg = 0; rg < 2; ++rg) {
        const int b0 = P->cu[l + 1][rg][0], e0 = P->cu[l + 1][rg][1];
        const int nb3 = e0 - b0;
        const int pb = b0 + (int)((long long)nb3 * (part == 0 ? 0 : part == 1 ? 4 : 6) / 10);
        const int pe = b0 + (int)((long long)nb3 * (part == 0 ? 4 : part == 1 ? 6 : 10) / 10);
        __syncthreads();
        convert_range(P, smem, pb, pe, worker, nworkers);
      }
    }
  }
}
DI void phase_inproj(PP P, int l, char* smem) {
  asm volatile("" : "+s"(P));
  char* ws = P->ws;
  const int li = l >> 1; const bool odd = l & 1;
  const int NT = odd ? 25 : 18;
  const u16* Bt = odd ? (const u16*)(ws + OFF_WINO) + (size_t)li * 3200 * 1024 : (const u16*)(ws + OFF_WINE) + (size_t)li * 2304 * 1024;
  TileMap tmap; tmap.init(96, NT, 4);
  for (int q = tmap.j; q < tmap.per_x; q += tmap.nloc) {
    int tn, tm; tmap.get(q, tm, tn);
    const int m0 = tm * 128, cond = cond_of_row(m0);
    ALBf16 al; al.A = (const u16*)(ws + OFF_OMIX); al.lda = 1024;
    if (odd) { EpiOdd ep; ep.P = P; gemm_tile<3>(al, Bt, 1024, 1024, m0, tn * 128, ep, smem); }
    else { EpiEven ep; ep.P = P; ep.li = li; gemm_tile<3>(al, Bt, 1024, 1024, m0, tn * 128, ep, smem); }
  }
}

DI void phase_upproj(PP P, int l, char* smem) {
  asm volatile("" : "+s"(P));
  char* ws = P->ws; const int li = l >> 1;
  {
    TileMap tmap; tmap.init(112, 8, 2);
    for (int q = tmap.j; q < tmap.per_x; q += tmap.nloc) {
      int tn, tm; tmap.get(q, tm, tn);
      EpiUpKV ep; ep.P = P;
      const u16* Bt = (const u16*)(ws + OFF_WUKV) + (size_t)li * 1024 * 256;
      if (tm < 96) {
        const int m0 = tm * 128;
        ALBf16Norm al; al.A = (const u16*)(ws + OFF_CKV); al.lda = 256; al.K = 256; al.g = P->in[19] + (size_t)li * 256;
        al.outn = nullptr; al.out_ld = 0;
        if (tn == 0 && m0 < MP_) {
          const int b = m0 >> 8, tt = m0 & 255;
          al.outn = P->out + OUT_CKV + ((size_t)(b * 2 + li) * 256 + tt) * 256; al.out_ld = 256;
        }
        gemm_tile<2>(al, Bt, 256, 256, m0, tn * 128, ep, smem);
      } else {
        const int cr = (tm - 96) * 128; const int b = cr >> 9, key = cr & 511;
        ALF32 al; al.A = P->in[2] + ((size_t)(b * 2 + li) * 512 + key) * 256 - (size_t)(M_ + cr) * 256; al.lda = 256;
        gemm_tile<1>(al, Bt, 256, 256, M_ + cr, tn * 128, ep, smem);
      }
    }
  }
  {
    TileMap tmap; tmap.init(96, 6, 4);
    for (int q = tmap.j; q < tmap.per_x; q += tmap.nloc) {
      int tn, tm; tmap.get(q, tm, tn);
      ALBf16Norm al; al.A = (const u16*)(ws + OFF_CQ); al.lda = 384; al.K = 384; al.g = P->in[17] + (size_t)li * 384; al.outn = nullptr; al.out_ld = 0;
      EpiUpQ ep; ep.P = P;
      gemm_tile<2>(al, (const u16*)(ws + OFF_WUQ) + (size_t)li * 768 * 384, 384, 384, tm * 128, tn * 128, ep, smem);
    }
  }
}

#define XB_TMO      128
#define XB_XCNT(j)  (256  + 64 * (j))
#define XB_XSUB(j)  (1280 + 64 * (j))
#define XB_XGEN(j)  (2304 + 64 * (j))
#define XB_TOP      3328
#define XB_TOPGEN   3392
#define XCD_BAR_WORDS 3456
#define XB_SPIN_CAP (1u << 18)
#define LAS __attribute__((address_space(3)))
DI unsigned xb_ld(unsigned* p) { return __hip_atomic_load(p, __ATOMIC_RELAXED, __HIP_MEMORY_SCOPE_AGENT); }
DI unsigned xb_add(unsigned* p, unsigned v) { return __hip_atomic_fetch_add(p, v, __ATOMIC_RELAXED, __HIP_MEMORY_SCOPE_AGENT); }
DI unsigned xb_xcc_id() { return (unsigned)__builtin_amdgcn_s_getreg((3 << 11) | 20) & 0xFu; }
#define XB_SPIN(cond, bar) do { unsigned _sp = 0; while (cond) { __builtin_amdgcn_s_sleep(1); \
    if ((++_sp & 255u) == 0u) { if (xb_ld(&(bar)[XB_TMO])) break; if (_sp > XB_SPIN_CAP) { atomicAdd(&(bar)[XB_TMO], 1u); break; } } } } while (0)
struct XcdBarrier { unsigned* bar; unsigned x; volatile LAS unsigned* st; };
DI XcdBarrier xcd_barrier_post(unsigned* bar, volatile LAS unsigned* st) {
  XcdBarrier b; b.bar = bar; b.x = xb_xcc_id(); b.st = st;
  if (tidx() == 0) (void)xb_add(&bar[XB_XCNT(b.x)], 1u);
  return b;
}
DI void xcd_barrier_complete(unsigned* bar, unsigned x, unsigned& nloc, unsigned& nx) {
  const unsigned G = gridDim.x * gridDim.y * gridDim.z;
  unsigned sum, cnt, mine, sp = 0u;
  for (;;) {
    sum = 0u; cnt = 0u; mine = 0u;
#pragma unroll
    for (unsigned j = 0; j < 16; ++j) { const unsigned c = xb_ld(&bar[XB_XCNT(j)]); sum += c; cnt += (c > 0u) ? 1u : 0u; mine = (j == x) ? c : mine; }
    if (sum == G) break;
    __builtin_amdgcn_s_sleep(1);
    if ((++sp & 255u) == 0u) { if (xb_ld(&bar[XB_TMO])) break; if (sp > XB_SPIN_CAP) { atomicAdd(&bar[XB_TMO], 1u); break; } }
  }
  nloc = mine > 0u ? mine : 1u; nx = cnt > 0u ? cnt : 1u;
}
DI void xcd_barrier(const XcdBarrier& b) {
  asm volatile("s_waitcnt vmcnt(0)" ::: "memory");
  __syncthreads();
  if (tidx() == 0) {
    unsigned* bar = b.bar;
    __builtin_amdgcn_s_waitcnt(0);
    unsigned nloc = b.st[0], nx = b.st[1];
    if (nloc == 0u) { xcd_barrier_complete(bar, b.x, nloc, nx); b.st[0] = nloc; b.st[1] = nx; }
    const unsigned old = xb_add(&bar[XB_XSUB(b.x)], 1u);
    const unsigned gen = old / nloc;
    if (old + 1u == (gen + 1u) * nloc) {
      __builtin_amdgcn_fence(__ATOMIC_RELEASE, "agent");
      asm volatile("s_waitcnt vmcnt(0)" ::: "memory");
      const unsigned og = xb_add(&bar[XB_TOP], 1u);
      const unsigned tg = og / nx;
      if (og + 1u == (tg + 1u) * nx) xb_add(&bar[XB_TOPGEN], 1u);
      else XB_SPIN(xb_ld(&bar[XB_TOPGEN]) == tg, bar);
      __builtin_amdgcn_fence(__ATOMIC_ACQUIRE, "agent");
      xb_add(&bar[XB_XGEN(b.x)], 1u);
      asm volatile("s_waitcnt vmcnt(0)" ::: "memory");
    } else {
      XB_SPIN(xb_ld(&bar[XB_XGEN(b.x)]) == gen, bar);
      __builtin_amdgcn_fence(__ATOMIC_ACQUIRE, "agent");
      asm volatile("s_waitcnt vmcnt(0)" ::: "memory");
    }
  }
  __syncthreads();
}

#ifndef PHSEL
#define PHSEL 511
#endif
#ifndef REPEAT_MASK
#define REPEAT_MASK 0
#endif
__global__ void __launch_bounds__(NTHR, 2) mega(Params Parg, int ph_lo, int ph_hi) {
  extern __shared__ __attribute__((aligned(16))) char smem[];
  cg::grid_group grid = cg::this_grid();
  PP Pk = (PP)__builtin_amdgcn_kernarg_segment_ptr();
  __shared__ __attribute__((aligned(16))) unsigned xb_words[4];
  if (tidx() < 4) xb_words[tidx()] = 0u;
  __syncthreads();
  const XcdBarrier xb = xcd_barrier_post((unsigned*)(Pk->ws + OFF_BAR), (volatile LAS unsigned*)xb_words);
  auto gsync_cg = [&]() {
    asm volatile("s_waitcnt vmcnt(0) lgkmcnt(0)" ::: "memory");
    __syncthreads();
    if (tidx() < 64) {
      __builtin_amdgcn_fence(__ATOMIC_RELEASE, "agent");
      asm volatile("s_waitcnt vmcnt(0)" ::: "memory");
    }
    grid.sync();
    __builtin_amdgcn_fence(__ATOMIC_ACQUIRE, "agent");
    asm volatile("s_waitcnt vmcnt(0)" ::: "memory");
  };
  for (int ph = ph_lo; ph < ph_hi; ++ph) {
    int kind;
    const int l = (ph - 1) / 12, s = (ph - 1) % 12;
    const bool odd = l & 1; const int li = l >> 1;
    if (ph == 0) kind = 0; else if (ph == 49) kind = 9;
    else kind = (s == 0 || s == 3 || s == 9) ? 10 : (s == 1 || s == 10) ? 1 : (s == 2 || s == 11) ? 2 : s == 4 ? 3 : s == 5 ? (odd ? 11 : 12)
              : s == 6 ? (odd ? 7 : 4) : s == 7 ? (odd ? 8 : 5) : 6;
    if (kind == 12) continue;
    if (ph > ph_lo) {
      if (ph_hi < 0) gsync_cg(); else xcd_barrier(xb);
#if (REPEAT_MASK) & 1024
      xcd_barrier(xb);
#endif
    }
    PP P = Pk;
    const int nrep = (((REPEAT_MASK) >> kind) & 1) ? 2 : 1;
    for (int rep = 0; rep < nrep; ++rep) {
      if (rep) xcd_barrier(xb);
      switch (kind) {
        case 0: phase_init(P, smem); break;
        case 9: phase_final(P); break;
        case 10: phase_hprep(P, l, s == 0 ? 0 : s == 3 ? 1 : 2); break;
        case 11: phase_gateprep(P, l); break;
        case 1: phase_ffn_up(P, l, s == 10 ? 1 : 0, smem); break;
        case 2: phase_resid_gemm(P, l, OFF_ACT, 2816, OFF_WD + (size_t)(l * 2 + (s == 11 ? 1 : 0)) * 1024 * 2816 * 2, s == 11 ? 8 : 2, 0.5f, s == 11 ? l * 3 + 3 : l * 3 + 1, smem, s == 11 ? 2 : 0); break;
        case 3: phase_inproj(P, l, smem); break;
        case 4: phase_upproj(P, l, smem); break;
        case 5: phase_attn(P, l, smem, l + 8 * rep); break;
        case 6: phase_resid_gemm(P, l, OFF_OMIX, 1024, (odd ? OFF_WOUTO : OFF_WOUTE) + (size_t)li * 1024 * 1024 * 2, 5, 1.0f, l * 3 + 2, smem, 1); break;
        case 7: phase_scan(P, l, smem, l + 8 * rep); break;
        case 8: phase_combine(P, l); break;
      }
    }
  }
}

static void add_job(Params& p, const float* src, u16* dst, int ld_src, int col0, int src_stride, int cpu, int row0, int dst_stride, int units, int K,
                    int ld_dst, int nrep = 1, int src_rep = 0, int dst_rep = 0) {
  Job& j = p.jobs[p.njobs++];
  j.src = src; j.dst = dst; j.ld_src = ld_src; j.col0 = col0; j.src_stride = src_stride; j.cpu = cpu; j.row0 = row0; j.dst_stride = dst_stride;
  j.units = units; j.K = K; j.ld_dst = ld_dst; j.nrep = nrep; j.src_rep = src_rep; j.dst_rep = dst_rep;
}

#ifndef MULTI_LAUNCH
#define MULTI_LAUNCH 0
#endif

extern "C" void kernel_launch(void* const* d_in, const int* in_sizes, int n_in, void* d_out, int out_size, void* d_ws, size_t ws_size, hipStream_t stream) {
  static Params p;
  memset(&p, 0, sizeof(p));
  for (int i = 0; i < 32; ++i) p.in[i] = (const float*)d_in[i];
  p.out = (float*)d_out; p.ws = (char*)d_ws;
  if (ws_size < WS_TOTAL) { fprintf(stderr, "workspace too small: %zu < %zu\n", ws_size, (size_t)WS_TOTAL); return; }
  char* ws = (char*)d_ws;
  for (int l = 0; l < 4; ++l)
    for (int f = 0; f < 2; ++f) {
      const size_t wi = (size_t)(l * 2 + f);
      u16* gu = (u16*)(ws + OFF_WGU) + wi * 5632 * 1024;
      add_job(p, (const float*)d_in[13] + wi * 1024 * 2816, gu, 2816, 0, 32, 32, 0, 64, 88, 1024, 1024);
      add_job(p, (const float*)d_in[14] + wi * 1024 * 2816, gu, 2816, 0, 32, 32, 32, 64, 88, 1024, 1024);
      add_job(p, (const float*)d_in[15] + wi * 2816 * 1024, (u16*)(ws + OFF_WD) + wi * 1024 * 2816, 1024, 0, 64, 64, 0, 64, 16, 2816, 2816);
    }
  for (int i = 0; i < 2; ++i) {
    const float* win = (const float*)d_in[16] + (size_t)i * 1024 * 2208;
    u16* wd = (u16*)(ws + OFF_WINE) + (size_t)i * 2304 * 1024;
    add_job(p, win, wd, 2208, 0, 64, 64, 0, 64, 10, 1024, 1024);
    add_job(p, win, wd, 2208, 672, 64, 64, 640, 64, 24, 1024, 1024);
    add_job(p, win, wd, 2208, 640, 32, 32, 2176, 32, 1, 1024, 1024);
    const float* wuq = (const float*)d_in[18] + (size_t)i * 384 * 768;
    u16* wq = (u16*)(ws + OFF_WUQ) + (size_t)i * 768 * 384;
    add_job(p, wuq, wq, 768, 0, 96, 64, 0, 64, 8, 384, 384);
    add_job(p, wuq, wq, 768, 64, 96, 32, 512, 32, 8, 384, 384);
    add_job(p, (const float*)d_in[20] + (size_t)i * 256 * 1024, (u16*)(ws + OFF_WUKV) + (size_t)i * 1024 * 256, 1024, 0, 64, 64, 0, 64, 16, 256, 256);
    add_job(p, (const float*)d_in[23] + (size_t)i * 1024 * 1024, (u16*)(ws + OFF_WOUTE) + (size_t)i * 1024 * 1024, 1024, 0, 64, 64, 0, 64, 16, 1024, 1024);
    const float* wo = (const float*)d_in[24] + (size_t)i * 1024 * 3104;
    u16* wod = (u16*)(ws + OFF_WINO) + (size_t)i * 3200 * 1024;
    add_job(p, wo, wod, 3104, 0, 64, 64, 0, 64, 16, 1024, 1024);
    add_job(p, wo, wod, 3104, 1056, 64, 64, 1024, 64, 32, 1024, 1024);
    add_job(p, wo, wod, 3104, 1024, 32, 32, 3072, 32, 1, 1024, 1024);
    add_job(p, (const float*)d_in[30] + (size_t)i * 1024 * 1024, (u16*)(ws + OFF_WOUTO) + (size_t)i * 1024 * 1024, 1024, 0, 64, 64, 0, 64, 16, 1024, 1024);
  }
  add_job(p, (const float*)d_in[5], (u16*)(ws + OFF_VDT_L), 512, 0, 64, 64, 0, 64, 8, 512, 2560, 8, 512 * 512, 4 * 128 * 2560);

  {
    int F[MAXJOBS + 1]; F[0] = 0;
    for (int j = 0; j < p.njobs; ++j) F[j + 1] = F[j] + p.jobs[j].units * (p.jobs[j].K >> 6) * p.jobs[j].nrep;
    for (int l = 0; l < 4; ++l) {
      p.cu[l][0][0] = F[6 * l]; p.cu[l][0][1] = F[6 * l + 6];
      const int i = l >> 1, base = 24 + 11 * i;
      if (l & 1) { p.cu[l][1][0] = F[base + 7]; p.cu[l][1][1] = F[base + 11]; }
      else { p.cu[l][1][0] = F[base]; p.cu[l][1][1] = F[base + 7]; }
    }
    p.cu_cache[0] = F[46]; p.cu_cache[1] = F[47];
  }
  static int grid_blocks = 0;
  if (!grid_blocks) {
    int dev = 0, cus = 0, per_cu = 0;
    hipGetDevice(&dev);
    hipDeviceGetAttribute(&cus, hipDeviceAttributeMultiprocessorCount, dev);
    hipFuncSetAttribute((const void*)mega, hipFuncAttributeMaxDynamicSharedMemorySize, SMEM_BYTES);
    hipOccupancyMaxActiveBlocksPerMultiprocessor(&per_cu, mega, NTHR, SMEM_BYTES);
    if (per_cu > 2) per_cu = 2;
    if (per_cu < 1) per_cu = 1;
    grid_blocks = cus * per_cu;
  }
  hipMemsetAsync(ws + OFF_CNT, 0, 256 + 16384, stream);
#if MULTI_LAUNCH
  for (int ph = 0; ph < 50; ++ph) hipLaunchKernelGGL(mega, dim3(grid_blocks), dim3(NTHR), SMEM_BYTES, stream, p, ph, ph + 1);
#else
  int lo = 0, hi = 50;
  void* args[] = {&p, &lo, &hi};
  hipError_t e = hipLaunchCooperativeKernel((void*)mega, dim3(grid_blocks), dim3(NTHR), args, SMEM_BYTES, stream);
  if (e != hipSuccess) fprintf(stderr, "cooperative launch failed: %s (grid %d)\n", hipGetErrorString(e), grid_blocks);
#endif
}
```
